# Optimizing an MI355X kernel written in HIP

```python
import jax
import jax.numpy as jnp
from jax import lax
import numpy as np

D_MODEL = 1024
BATCH = 2
SEQ = 8192
DEPTH = 2

GRID_W = 64
CTX_LEN = 256
HEAD_DIM = 64
FOURIER_GROUPS = 4
FOURIER_GROUP_DIM = 64
FOURIER_WIDTH = FOURIER_GROUPS * FOURIER_GROUP_DIM
RET_HEADS = 4
RET_DK = 64
RET_DV = 64
RET_QK_WIDTH = RET_HEADS * RET_DK
RET_WIDTH = RET_HEADS * RET_DV
RET_CHUNK = 128
ATT_HEADS = 8
ATT_KV_HEADS = 2
ATT_GROUP = ATT_HEADS // ATT_KV_HEADS
ATT_WIDTH = ATT_HEADS * HEAD_DIM
ATT_KV_WIDTH = ATT_KV_HEADS * HEAD_DIM
WINDOW = 128
ATT_BLOCK = 128
KEY_SPAN = ATT_BLOCK + 2 * WINDOW
D_MIX = FOURIER_WIDTH + RET_WIDTH + ATT_WIDTH
D_FF = 2816
N_MOD = 9
ROPE_BASE = 10000.0
ROPE_AXIS_PAIRS = HEAD_DIM // 4
NORM_EPS = 1e-6
NEG_INF = -1e30
IN_SIZES = (FOURIER_WIDTH, RET_QK_WIDTH, RET_QK_WIDTH, RET_WIDTH, RET_WIDTH, ATT_WIDTH, ATT_KV_WIDTH, ATT_KV_WIDTH)
IN_OFFSETS = tuple(int(o) for o in np.cumsum(IN_SIZES)[:-1])
D_IN = int(sum(IN_SIZES))

kernel_name = 'hybrid_fourier_retention_swa_macaron_dit'


def rms_norm(x, w):
    xf = x.astype(jnp.float32)
    y = xf * lax.rsqrt(jnp.mean(xf * xf, axis=-1, keepdims=True) + NORM_EPS) * w.astype(jnp.float32)
    return y.astype(x.dtype)


def modulate(h, shift, scale):
    return h * (1.0 + scale) + shift


def swiglu(h, w_in, w_out):
    gate, up = jnp.split(h @ w_in, 2, axis=-1)
    return (jax.nn.silu(gate) * up) @ w_out


def to_heads(t, n_heads):
    return t.reshape(t.shape[0], t.shape[1], n_heads, t.shape[2] // n_heads)


def axial_rope_angles(length):
    rows = length // GRID_W
    row = jnp.repeat(jnp.arange(rows, dtype=jnp.float32), GRID_W)
    col = jnp.tile(jnp.arange(GRID_W, dtype=jnp.float32), rows)
    inv_freq = ROPE_BASE ** (-jnp.arange(ROPE_AXIS_PAIRS, dtype=jnp.float32) / ROPE_AXIS_PAIRS)
    ang = jnp.stack([row[:, None] * inv_freq, col[:, None] * inv_freq], axis=1)
    return jnp.cos(ang), jnp.sin(ang)


def apply_axial_rope(x, cos, sin):
    b, l, h, d = x.shape
    xr = x.astype(jnp.float32).reshape(b, l, h, 2, 2, ROPE_AXIS_PAIRS)
    x1, x2 = xr[..., 0, :], xr[..., 1, :]
    cs, sn = cos[:, None], sin[:, None]
    out = jnp.stack([x1 * cs - x2 * sn, x2 * cs + x1 * sn], axis=-2)
    return out.reshape(b, l, h, d).astype(x.dtype)


def fourier_mix(u):
    b, l, _ = u.shape
    g = u.astype(jnp.float32).reshape(b, l, FOURIER_GROUPS, FOURIER_GROUP_DIM)
    y = jnp.fft.fft2(g, axes=(1, 3), norm='ortho').real
    return y.reshape(b, l, FOURIER_WIDTH).astype(u.dtype)


def retention_scan(q, k, v, log_gamma, state0):
    b, l, h, _ = q.shape
    dv = v.shape[-1]
    n = l // RET_CHUNK
    cl = RET_CHUNK

    def chunks(t):
        return t.reshape(b, n, cl, h, t.shape[-1]).transpose(1, 0, 3, 2, 4)

    qc, kc, vc = chunks(q), chunks(k), chunks(v)
    pos = jnp.arange(cl, dtype=jnp.float32)
    diff = pos[:, None] - pos[None, :]
    causal = diff >= 0
    intra_decay = jnp.where(causal[None], jnp.exp(jnp.where(causal, diff, 0.0)[None] * log_gamma[:, None, None]), 0.0)
    q_decay = jnp.exp((pos + 1.0)[None] * log_gamma[:, None])
    k_decay = jnp.exp((cl - 1.0 - pos)[None] * log_gamma[:, None])
    chunk_decay = jnp.exp(cl * log_gamma)
    scores = jnp.einsum('nbhik,nbhjk->nbhij', qc, kc) * intra_decay
    intra = jnp.einsum('nbhij,nbhjv->nbhiv', scores, vc)
    kv = jnp.einsum('nbhjk,hj,nbhjv->nbhkv', kc, k_decay, vc)

    def step(state, kv_chunk):
        return state * chunk_decay[None, :, None, None] + kv_chunk, state

    state_final, state_in = lax.scan(step, state0, kv)
    cross = jnp.einsum('nbhik,nbhkv->nbhiv', qc, state_in) * q_decay[None, None, :, :, None]
    out = (intra + cross).transpose(1, 0, 3, 2, 4).reshape(b, l, h, dv)
    return out, state_final


def bidirectional_retention(q_lat, k_lat, v_lat, q_ctx, k_ctx, v_ctx, log_gamma):
    f32 = jnp.float32
    scale = RET_DK ** -0.5
    q_lat, v_lat, q_ctx, v_ctx = q_lat.astype(f32), v_lat.astype(f32), q_ctx.astype(f32), v_ctx.astype(f32)
    k_lat = k_lat.astype(f32) * scale
    k_ctx = k_ctx.astype(f32) * scale
    state0 = jnp.zeros((q_lat.shape[0], RET_HEADS, RET_DK, RET_DV), f32)
    outs_lat = []
    outs_ctx = []
    for direction in range(2):
        if direction == 0:
            rev = lambda t: t
        else:
            rev = lambda t: jnp.flip(t, axis=1)
        o_c, s_c = retention_scan(rev(q_ctx), rev(k_ctx), rev(v_ctx), log_gamma[direction], state0)
        o_l, _ = retention_scan(rev(q_lat), rev(k_lat), rev(v_lat), log_gamma[direction], s_c)
        outs_ctx.append(rev(o_c))
        outs_lat.append(rev(o_l))
    return outs_lat[0] + outs_lat[1], outs_ctx[0] + outs_ctx[1]


def retention_output(o, gate, gn_w):
    b, l = o.shape[0], o.shape[1]
    mu = jnp.mean(o, axis=-1, keepdims=True)
    var = jnp.mean(jnp.square(o - mu), axis=-1, keepdims=True)
    on = ((o - mu) * lax.rsqrt(var + NORM_EPS)).reshape(b, l, RET_WIDTH) * gn_w.astype(jnp.float32)
    return (jax.nn.silu(gate.astype(jnp.float32)) * on).astype(gate.dtype)


def windowed_attention_latent(q, k, v, k_ctx, v_ctx, sink):
    b, s = q.shape[0], q.shape[1]
    nb = s // ATT_BLOCK
    f32 = jnp.float32
    qb = q.astype(f32).reshape(b, nb, ATT_BLOCK, ATT_KV_HEADS, ATT_GROUP, HEAD_DIM) * (HEAD_DIM ** -0.5)
    pad = ((0, 0), (WINDOW, WINDOW), (0, 0), (0, 0))
    kp = jnp.pad(k.astype(f32), pad)
    vp = jnp.pad(v.astype(f32), pad)
    block_start = jnp.arange(nb) * ATT_BLOCK
    key_idx = block_start[:, None] + jnp.arange(KEY_SPAN)[None, :]
    kw = kp[:, key_idx]
    vw = vp[:, key_idx]
    key_pos = key_idx - WINDOW
    q_pos = block_start[:, None] + jnp.arange(ATT_BLOCK)[None, :]
    rel = key_pos[:, None, :] - q_pos[:, :, None]
    valid = (jnp.abs(rel) <= WINDOW) & (key_pos[:, None, :] >= 0) & (key_pos[:, None, :] < s)
    s_loc = jnp.einsum('bnqhgd,bnkhd->bnhgqk', qb, kw)
    s_loc = jnp.where(valid[None, :, None, None], s_loc, NEG_INF)
    s_ctx = jnp.einsum('bnqhgd,bchd->bnhgqc', qb, k_ctx.astype(f32))
    sink_l = sink.astype(f32).reshape(1, 1, ATT_KV_HEADS, ATT_GROUP, 1, 1)
    m = jnp.maximum(jnp.maximum(s_loc.max(-1, keepdims=True), s_ctx.max(-1, keepdims=True)), sink_l)
    p_loc = jnp.exp(s_loc - m)
    p_ctx = jnp.exp(s_ctx - m)
    denom = p_loc.sum(-1, keepdims=True) + p_ctx.sum(-1, keepdims=True) + jnp.exp(sink_l - m)
    o = jnp.einsum('bnhgqk,bnkhd->bnqhgd', p_loc / denom, vw) + jnp.einsum('bnhgqc,bchd->bnqhgd', p_ctx / denom, v_ctx.astype(f32))
    return o.reshape(b, s, ATT_WIDTH).astype(q.dtype)


def context_attention(q, k, v, sink):
    b, l = q.shape[0], q.shape[1]
    f32 = jnp.float32
    qg = q.astype(f32).reshape(b, l, ATT_KV_HEADS, ATT_GROUP, HEAD_DIM) * (HEAD_DIM ** -0.5)
    sc = jnp.einsum('blhgd,bmhd->bhglm', qg, k.astype(f32))
    sink_l = sink.astype(f32).reshape(1, ATT_KV_HEADS, ATT_GROUP, 1, 1)
    m = jnp.maximum(sc.max(-1, keepdims=True), sink_l)
    p = jnp.exp(sc - m)
    denom = p.sum(-1, keepdims=True) + jnp.exp(sink_l - m)
    o = jnp.einsum('bhglm,bmhd->blhgd', p / denom, v.astype(f32))
    return o.reshape(b, l, ATT_WIDTH).astype(q.dtype)


def token_mix(h_lat, h_ctx, w_in, w_o, log_gamma, gn_w, sink, rope_cos, rope_sin, need_ctx_out):
    f_l, rq_l, rk_l, rv_l, rg_l, aq_l, ak_l, av_l = jnp.split(h_lat @ w_in, IN_OFFSETS, axis=-1)
    f_c, rq_c, rk_c, rv_c, rg_c, aq_c, ak_c, av_c = jnp.split(h_ctx @ w_in, IN_OFFSETS, axis=-1)
    rq_l = apply_axial_rope(to_heads(rq_l, RET_HEADS), rope_cos, rope_sin)
    rk_l = apply_axial_rope(to_heads(rk_l, RET_HEADS), rope_cos, rope_sin)
    ret_l, ret_c = bidirectional_retention(rq_l, rk_l, to_heads(rv_l, RET_HEADS), to_heads(rq_c, RET_HEADS), to_heads(rk_c, RET_HEADS), to_heads(rv_c, RET_HEADS), log_gamma)
    y_ret = retention_output(ret_l, rg_l, gn_w)
    aq_l = apply_axial_rope(to_heads(aq_l, ATT_HEADS), rope_cos, rope_sin)
    ak_l = apply_axial_rope(to_heads(ak_l, ATT_KV_HEADS), rope_cos, rope_sin)
    ak_c = to_heads(ak_c, ATT_KV_HEADS)
    av_c = to_heads(av_c, ATT_KV_HEADS)
    y_att = windowed_attention_latent(aq_l, ak_l, to_heads(av_l, ATT_KV_HEADS), ak_c, av_c, sink)
    y_f = fourier_mix(f_l)
    out_lat = jnp.concatenate([y_f, y_ret, y_att], axis=-1) @ w_o
    if not need_ctx_out:
        return out_lat, None
    y_c = jnp.concatenate([fourier_mix(f_c), retention_output(ret_c, rg_c, gn_w), context_attention(to_heads(aq_c, ATT_HEADS), ak_c, av_c, sink)], axis=-1)
    return out_lat, y_c @ w_o


def setup_inputs(seed: int = 0) -> dict:
    key = jax.random.key(seed)
    ks = jax.random.split(key, 16)
    nrm = jax.random.normal
    f32 = jnp.float32
    x = nrm(ks[0], (BATCH, SEQ, D_MODEL), f32)
    c = nrm(ks[1], (BATCH, D_MODEL), f32)
    ctx = nrm(ks[2], (BATCH, CTX_LEN, D_MODEL), f32)
    c_ctx = nrm(ks[3], (D_MODEL,), f32)
    norm_w = 1.0 + 0.05 * nrm(ks[4], (DEPTH, 3, D_MODEL), f32)
    w_ada = nrm(ks[5], (DEPTH, D_MODEL, N_MOD * D_MODEL), f32) * (0.5 * D_MODEL ** -0.5)
    b_ada = 0.02 * nrm(ks[6], (DEPTH, N_MOD * D_MODEL), f32)
    ffn_w_in = nrm(ks[7], (DEPTH, 2, D_MODEL, 2 * D_FF), f32) * (D_MODEL ** -0.5)
    ffn_w_out = nrm(ks[8], (DEPTH, 2, D_FF, D_MODEL), f32) * (D_FF ** -0.5)
    w_in = nrm(ks[9], (DEPTH, D_MODEL, D_IN), f32) * (D_MODEL ** -0.5)
    w_o = nrm(ks[10], (DEPTH, D_MIX, D_MODEL), f32) * (D_MIX ** -0.5)
    base_logit = jnp.asarray(np.log(2.0 ** (5.0 + np.arange(RET_HEADS)) - 1.0).astype(np.float32))
    ret_decay = base_logit[None, None, :] + 0.1 * nrm(ks[11], (DEPTH, 2, RET_HEADS), f32)
    ret_gn_w = 1.0 + 0.05 * nrm(ks[12], (DEPTH, RET_WIDTH), f32)
    attn_sink = 0.5 * nrm(ks[13], (DEPTH, ATT_HEADS), f32)
    final_norm_w = 1.0 + 0.05 * nrm(ks[14], (D_MODEL,), f32)
    return {'x': x, 'c': c, 'ctx': ctx, 'c_ctx': c_ctx, 'norm_w': norm_w, 'w_ada': w_ada, 'b_ada': b_ada,
            'ffn_w_in': ffn_w_in, 'ffn_w_out': ffn_w_out, 'w_in': w_in, 'w_o': w_o, 'ret_decay': ret_decay,
            'ret_gn_w': ret_gn_w, 'attn_sink': attn_sink, 'final_norm_w': final_norm_w}


def reference(x, c, ctx, c_ctx, norm_w, w_ada, b_ada, ffn_w_in, ffn_w_out, w_in, w_o, ret_decay, ret_gn_w, attn_sink, final_norm_w):
    rope_cos, rope_sin = axial_rope_angles(x.shape[1])
    cond_lat = jax.nn.silu(c)
    cond_ctx = jax.nn.silu(c_ctx)
    h = x
    hc = ctx
    for layer in range(DEPTH):
        need_ctx_out = layer < DEPTH - 1
        mod = (cond_lat @ w_ada[layer] + b_ada[layer]).reshape(x.shape[0], N_MOD, 1, D_MODEL)
        mod_c = (cond_ctx @ w_ada[layer] + b_ada[layer]).reshape(N_MOD, 1, D_MODEL)
        lm = [mod[:, i] for i in range(N_MOD)]
        cm = [mod_c[i] for i in range(N_MOD)]
        h = h + 0.5 * lm[2] * swiglu(modulate(rms_norm(h, norm_w[layer, 0]), lm[0], lm[1]), ffn_w_in[layer, 0], ffn_w_out[layer, 0])
        hc = hc + 0.5 * cm[2] * swiglu(modulate(rms_norm(hc, norm_w[layer, 0]), cm[0], cm[1]), ffn_w_in[layer, 0], ffn_w_out[layer, 0])
        y, yc = token_mix(modulate(rms_norm(h, norm_w[layer, 1]), lm[3], lm[4]),
                          modulate(rms_norm(hc, norm_w[layer, 1]), cm[3], cm[4]),
                          w_in[layer], w_o[layer], jax.nn.log_sigmoid(ret_decay[layer].astype(jnp.float32)),
                          ret_gn_w[layer], attn_sink[layer], rope_cos, rope_sin, need_ctx_out)
        h = h + lm[5] * y
        h = h + 0.5 * lm[8] * swiglu(modulate(rms_norm(h, norm_w[layer, 2]), lm[6], lm[7]), ffn_w_in[layer, 1], ffn_w_out[layer, 1])
        if need_ctx_out:
            hc = hc + cm[5] * yc
            hc = hc + 0.5 * cm[8] * swiglu(modulate(rms_norm(hc, norm_w[layer, 2]), cm[6], cm[7]), ffn_w_in[layer, 1], ffn_w_out[layer, 1])
    return rms_norm(h, final_norm_w)
```

```cpp
#define FUSE_NORM 0
#include <hip/hip_runtime.h>
#include <hip/hip_cooperative_groups.h>
#include <cstdio>
#include <cstdint>

__device__ __forceinline__ int tidx() { int t = threadIdx.x; asm volatile("" : "+v"(t)); return t; }
__device__ __forceinline__ int bidx() { int t = blockIdx.x; asm volatile("" : "+s"(t)); return t; }
__device__ __forceinline__ int gdim() { int t = gridDim.x; asm volatile("" : "+s"(t)); return t; }
#define LAS __attribute__((address_space(3)))
#define XB_TMO      128
#define XB_XCNT(j)  (256  + 64 * (j))
#define XB_XSUB(j)  (1280 + 64 * (j))
#define XB_XGEN(j)  (2304 + 64 * (j))
#define XB_TOP      3328
#define XB_TOPGEN   3392
#define XCD_BAR_WORDS 3456
#define XB_SPIN_CAP (1u << 18)

__device__ __forceinline__ unsigned xb_ld(unsigned* p)              { return __hip_atomic_load(p, __ATOMIC_RELAXED, __HIP_MEMORY_SCOPE_AGENT); }
__device__ __forceinline__ unsigned xb_add(unsigned* p, unsigned v) { return __hip_atomic_fetch_add(p, v, __ATOMIC_RELAXED, __HIP_MEMORY_SCOPE_AGENT); }
__device__ __forceinline__ unsigned xb_xcc_id() { return (unsigned)__builtin_amdgcn_s_getreg((3 << 11) | 20) & 0xFu; }
#define XB_SPIN(cond, bar) do { unsigned _sp = 0; while (cond) { __builtin_amdgcn_s_sleep(1); \
    if ((++_sp & 255u) == 0u) { if (xb_ld(&(bar)[XB_TMO])) break; if (_sp > XB_SPIN_CAP) { atomicAdd(&(bar)[XB_TMO], 1u); break; } } } } while (0)

struct XcdBarrier {
    unsigned* bar; unsigned x;
    volatile LAS unsigned* st;
};

__device__ __forceinline__ XcdBarrier xcd_barrier_post(unsigned* bar, volatile LAS unsigned* st) {
    XcdBarrier b; b.bar = bar; b.x = xb_xcc_id(); b.st = st;
    if (threadIdx.x == 0) (void)xb_add(&bar[XB_XCNT(b.x)], 1u);
    return b;
}
__device__ __forceinline__ void xcd_barrier_complete(unsigned* bar, unsigned x, unsigned& nloc, unsigned& nx) {
    const unsigned G = gridDim.x * gridDim.y * gridDim.z;
    unsigned sum, cnt, mine, sp = 0u;
    for (;;) {
        sum = 0u; cnt = 0u; mine = 0u;
#pragma unroll
        for (unsigned j = 0; j < 16; ++j) { const unsigned c = xb_ld(&bar[XB_XCNT(j)]); sum += c; cnt += (c > 0u) ? 1u : 0u; mine = (j == x) ? c : mine; }
        if (sum == G) break;
        __builtin_amdgcn_s_sleep(1);
        if ((++sp & 255u) == 0u) { if (xb_ld(&bar[XB_TMO])) break; if (sp > XB_SPIN_CAP) { atomicAdd(&bar[XB_TMO], 1u); break; } }
    }
    nloc = mine > 0u ? mine : 1u; nx = cnt > 0u ? cnt : 1u;
}

__device__ __forceinline__ void xcd_barrier(const XcdBarrier& b) {
    asm volatile("s_waitcnt vmcnt(0)" ::: "memory");
    __syncthreads();
    if (threadIdx.x == 0) {
        unsigned* bar = b.bar;
        __builtin_amdgcn_s_waitcnt(0);
        unsigned nloc = b.st[0], nx = b.st[1];
        if (nloc == 0u) { xcd_barrier_complete(bar, b.x, nloc, nx); b.st[0] = nloc; b.st[1] = nx; }
        const unsigned old = xb_add(&bar[XB_XSUB(b.x)], 1u);
        const unsigned gen = old / nloc;
        if (old + 1u == (gen + 1u) * nloc) {
            __builtin_amdgcn_fence(__ATOMIC_RELEASE, "agent");
            asm volatile("s_waitcnt vmcnt(0)" ::: "memory");
            const unsigned og = xb_add(&bar[XB_TOP], 1u);
            const unsigned tg = og / nx;
            if (og + 1u == (tg + 1u) * nx) xb_add(&bar[XB_TOPGEN], 1u);
            else XB_SPIN(xb_ld(&bar[XB_TOPGEN]) == tg, bar);
            __builtin_amdgcn_fence(__ATOMIC_ACQUIRE, "agent");
            xb_add(&bar[XB_XGEN(b.x)], 1u);
            asm volatile("s_waitcnt vmcnt(0)" ::: "memory");
        } else {
            XB_SPIN(xb_ld(&bar[XB_XGEN(b.x)]) == gen, bar);
            __builtin_amdgcn_fence(__ATOMIC_ACQUIRE, "agent");
            asm volatile("s_waitcnt vmcnt(0)" ::: "memory");
        }
    }
    __syncthreads();
}
namespace pg8 {
#define PG8_LAS __attribute__((address_space(3)))
typedef unsigned short bf16_t;
typedef short bf16x8 __attribute__((ext_vector_type(8)));
typedef float f32x4 __attribute__((ext_vector_type(4)));
typedef unsigned u32x4 __attribute__((ext_vector_type(4)));
constexpr int BM = 256, BK = 64, HALF = 128, HTB = HALF * BK * 2  , STAGE_BYTES = 8 * HTB, NXCD = 8, WGM = 4;

__host__ __device__ __forceinline__ int lds_byte(int r, int c) { const int st = (r >> 4) * 2 + (c >> 5), rr = r & 15, cc = c & 31, ob = rr * 64 + cc * 2; return st * 1024 + (ob ^ (((ob >> 9) & 1) << 5)); }
__host__ __device__ __forceinline__ void stage_rc(int b, int& R, int& C) { const int st = b / 1024, sb = b % 1024, swz = sb ^ (((sb >> 9) & 1) << 5); R = (st >> 1) * 16 + swz / 64; C = (st & 1) * 32 + (swz % 64) / 2; }
__host__ __device__ __forceinline__ int perm32(int rho) { const int n = rho >> 4, i = rho & 15; return 8 * (i >> 2) + 4 * n + (i & 3); }

struct Unit { int pm, pn; };
struct Gemm { const bf16_t* A; const bf16_t* Bt; int M, N, K; };

struct StaticOrder {
    int nM, nN, nwg, G, c;
    __host__ __device__ __forceinline__ void init(int M, int N, int G_, int c_) { nM = M / BM; nN = N / BM; nwg = nM * nN; G = G_; c = c_; }
    __host__ __device__ __forceinline__ bool next(int i, Unit& u) const {
        const long L = (long)i * G + c; if (L >= nwg) return false;
        int wgid = (int)L; { const int q = nwg / NXCD, r = nwg % NXCD, xcd = wgid % NXCD, off = wgid / NXCD; wgid = (xcd < r ? xcd * (q + 1) : r * (q + 1) + (xcd - r) * q) + off; }
        const int nig = WGM * nN, gid = wgid / nig, fm = gid * WGM, gsz = (nM - fm) < WGM ? (nM - fm) : WGM;
        u.pm = fm + ((wgid % nig) % gsz); u.pn = (wgid % nig) / gsz; return true;
    }
    __device__ __forceinline__ void a_ready(const Unit&) const {}
    __device__ __forceinline__ void done(const Unit&) const {}
};

__device__ __forceinline__ unsigned cvt_pk_bf16(float lo, float hi) { unsigned r; asm volatile("v_cvt_pk_bf16_f32 %0, %1, %2" : "=v"(r) : "v"(lo), "v"(hi)); return r; }
template <class Epi, class Sched, bool ALIGN_EPI = false, bool SP2 = false>
__device__ __forceinline__ void gemm_phase(PG8_LAS unsigned char* lds, const Gemm g, const Sched& S, const Epi& E) {
    const int tid = tidx(), wid = __builtin_amdgcn_readfirstlane(tid >> 6), lane = tid & 63, wr = wid >> 2, wc = wid & 3, fr = lane & 15, fq = lane >> 4;
    const int K = g.K, nt = K / BK;
    unsigned voffA[2], voffB[2];
#pragma unroll
    for (int i = 0; i < 2; ++i) { int R, C; stage_rc(tid * 16 + i * 8192, R, C); const int Rb = Epi::PERM ? ((R & ~31) + perm32(R & 31)) : R;
        voffA[i] = (unsigned)(R * K + C) * 2u; voffB[i] = (unsigned)(Rb * K + C) * 2u; }
    const size_t kstep = (size_t)(BK * 2);
    const size_t hstep = (size_t)HALF * K * 2;
    const size_t tstep = 2 * hstep;
    const unsigned ldsw = (unsigned)wid * 1024u;
    const int aoff = lds_byte(wr * 64 + fr, fq * 8), boff = lds_byte(wc * 32 + fr, fq * 8);
#define PG8_SA(b, h) (((b) * 2 + (h)) * HTB)
#define PG8_SB(b, h) ((4 + (b) * 2 + (h)) * HTB)
#define PG8_STAGE(bufoff, gbase, voff) do { _Pragma("unroll") for (int _i = 0; _i < 2; ++_i) \
        __builtin_amdgcn_global_load_lds((const unsigned*)((const char*)(gbase) + (voff)[_i]), (PG8_LAS unsigned*)(lds + (bufoff) + ldsw + _i * 8192), 16, 0, 0); } while (0)
#define PG8_LDA(dst, b, h) do { _Pragma("unroll") for (int m = 0; m < 4; ++m) _Pragma("unroll") for (int k = 0; k < 2; ++k) dst[m][k] = *(const PG8_LAS bf16x8*)(lds + PG8_SA(b, h) + aoff + m * 2048 + k * 1024); } while (0)
#define PG8_LDB(dst, b, h) do { _Pragma("unroll") for (int n = 0; n < 2; ++n) _Pragma("unroll") for (int k = 0; k < 2; ++k) dst[n][k] = *(const PG8_LAS bf16x8*)(lds + PG8_SB(b, h) + boff + n * 2048 + k * 1024); } while (0)
#define PG8_MMA(ai, bj, At, Bt) do { __builtin_amdgcn_s_setprio(1); _Pragma("unroll") for (int m = 0; m < 4; ++m) _Pragma("unroll") for (int n = 0; n < 2; ++n) _Pragma("unroll") for (int k = 0; k < 2; ++k) \
        acc[ai][bj][m][n] = __builtin_amdgcn_mfma_f32_16x16x32_bf16(Bt[n][k], At[m][k], acc[ai][bj][m][n], 0, 0, 0); __builtin_amdgcn_s_setprio(0); } while (0)
#define PG8_WAIT_V(n) asm volatile("s_waitcnt vmcnt(" #n ")" ::: "memory")
#define PG8_WAIT_L(n) asm volatile("s_waitcnt lgkmcnt(" #n ")" ::: "memory")
#define PG8_BAR __builtin_amdgcn_s_barrier()
#define PG8_SCHED __builtin_amdgcn_sched_barrier(0)
    Unit cur, nxt; int ui = 0;
    if (!S.next(0, cur)) return;
    f32x4 acc[2][2][4][2];
#pragma unroll
    for (int a = 0; a < 2; ++a)
#pragma unroll
        for (int b = 0; b < 2; ++b)
#pragma unroll
            for (int m = 0; m < 4; ++m)
#pragma unroll
                for (int n = 0; n < 2; ++n) acc[a][b][m][n] = (f32x4){0.f, 0.f, 0.f, 0.f};
    bf16x8 At[4][2], B0[2][2], B1[2][2];
    const char* cA = (const char*)g.A + (size_t)cur.pm * tstep; const char* cB = (const char*)g.Bt + (size_t)cur.pn * tstep;
    S.a_ready(cur);
    if constexpr (SP2) {
        PG8_STAGE(PG8_SB(0, 0), cB, voffB); PG8_STAGE(PG8_SB(0, 1), cB + hstep, voffB); PG8_STAGE(PG8_SA(0, 0), cA, voffA); PG8_STAGE(PG8_SA(0, 1), cA + hstep, voffA);
        if (wr == 1) PG8_BAR;
        PG8_WAIT_V(2); PG8_BAR;
        PG8_STAGE(PG8_SB(1, 0), cB + kstep, voffB); PG8_STAGE(PG8_SA(1, 0), cA + kstep, voffA); PG8_STAGE(PG8_SB(1, 1), cB + hstep + kstep, voffB);
        PG8_WAIT_V(6); PG8_BAR;
    } else {
        PG8_STAGE(PG8_SB(0, 0), cB, voffB); PG8_STAGE(PG8_SA(0, 0), cA, voffA); PG8_STAGE(PG8_SB(0, 1), cB + hstep, voffB); PG8_STAGE(PG8_SA(0, 1), cA + hstep, voffA);
        if (wr == 1) PG8_BAR;
        PG8_WAIT_V(4); PG8_BAR;
        PG8_STAGE(PG8_SB(1, 0), cB + kstep, voffB); PG8_STAGE(PG8_SA(1, 0), cA + kstep, voffA); PG8_STAGE(PG8_SB(1, 1), cB + hstep + kstep, voffB);
        PG8_WAIT_V(6); PG8_BAR;
    }
    for (;;) {
        const bool has_next = S.next(ui + 1, nxt);
        const char* nA = has_next ? (const char*)g.A + (size_t)nxt.pm * tstep : cA; const char* nB = has_next ? (const char*)g.Bt + (size_t)nxt.pn * tstep : cB;
        for (int t = 0; t < nt; t += 2) {
            const bool last = (t == nt - 2);
            const char* a1 = cA + (size_t)(t + 1) * kstep;
            const char* a2 = last ? nA : cA + (size_t)(t + 2) * kstep; const char* b2 = last ? nB : cB + (size_t)(t + 2) * kstep;
            const char* a3 = a2 + kstep; const char* b3 = b2 + kstep;
            if (last && has_next) S.a_ready(nxt);
            if constexpr (SP2) {
            PG8_LDB(B0, 0, 0); PG8_LDB(B1, 0, 1); PG8_SCHED; PG8_LDA(At, 0, 0); PG8_STAGE(PG8_SA(1, 1), a1 + hstep, voffA);
            PG8_WAIT_V(8); PG8_WAIT_L(0); PG8_BAR; PG8_MMA(0, 0, At, B0); PG8_MMA(0, 1, At, B1); PG8_BAR; PG8_SCHED;
            PG8_LDA(At, 0, 1); PG8_STAGE(PG8_SB(0, 0), b2, voffB); PG8_STAGE(PG8_SB(0, 1), b2 + hstep, voffB); PG8_STAGE(PG8_SA(0, 0), a2, voffA);
            PG8_WAIT_V(8); PG8_WAIT_L(0); PG8_BAR; PG8_MMA(1, 0, At, B0); PG8_MMA(1, 1, At, B1); PG8_BAR; PG8_SCHED;
            PG8_LDB(B0, 1, 0); PG8_LDB(B1, 1, 1); PG8_SCHED; PG8_LDA(At, 1, 0); PG8_STAGE(PG8_SA(0, 1), a2 + hstep, voffA);
            PG8_WAIT_V(8); PG8_WAIT_L(0); PG8_BAR; PG8_MMA(0, 0, At, B0); PG8_MMA(0, 1, At, B1); PG8_BAR; PG8_SCHED;
            PG8_LDA(At, 1, 1); PG8_STAGE(PG8_SB(1, 0), b3, voffB); PG8_STAGE(PG8_SB(1, 1), b3 + hstep, voffB); PG8_STAGE(PG8_SA(1, 0), a3, voffA);
            PG8_WAIT_V(8); PG8_WAIT_L(0); PG8_BAR; PG8_MMA(1, 0, At, B0); PG8_MMA(1, 1, At, B1); PG8_BAR; PG8_SCHED;
            } else {
            PG8_LDB(B0, 0, 0); PG8_SCHED; PG8_LDA(At, 0, 0); PG8_STAGE(PG8_SA(1, 1), a1 + hstep, voffA);
            PG8_WAIT_L(8); PG8_BAR; PG8_WAIT_L(0); PG8_MMA(0, 0, At, B0); PG8_BAR; PG8_SCHED;
            PG8_LDB(B1, 0, 1); PG8_STAGE(PG8_SB(0, 0), b2, voffB);
            PG8_BAR; PG8_WAIT_L(0); PG8_MMA(0, 1, At, B1); PG8_BAR;
            PG8_LDA(At, 0, 1); PG8_STAGE(PG8_SA(0, 0), a2, voffA);
            PG8_BAR; PG8_WAIT_L(0); PG8_MMA(1, 0, At, B0); PG8_BAR; PG8_SCHED;
            PG8_STAGE(PG8_SB(0, 1), b2 + hstep, voffB);
            PG8_WAIT_V(6); PG8_BAR; PG8_MMA(1, 1, At, B1); PG8_BAR;
            PG8_LDB(B0, 1, 0); PG8_SCHED; PG8_LDA(At, 1, 0); PG8_STAGE(PG8_SA(0, 1), a2 + hstep, voffA);
            PG8_WAIT_L(8); PG8_BAR; PG8_WAIT_L(0); PG8_MMA(0, 0, At, B0); PG8_BAR; PG8_SCHED;
            PG8_LDB(B1, 1, 1); PG8_STAGE(PG8_SB(1, 0), b3, voffB);
            PG8_BAR; PG8_WAIT_L(0); PG8_MMA(0, 1, At, B1); PG8_BAR;
            PG8_LDA(At, 1, 1); PG8_STAGE(PG8_SA(1, 0), a3, voffA);
            PG8_BAR; PG8_WAIT_L(0); PG8_MMA(1, 0, At, B0); PG8_BAR; PG8_SCHED;
            PG8_STAGE(PG8_SB(1, 1), b3 + hstep, voffB);
            PG8_WAIT_V(6); PG8_BAR; PG8_MMA(1, 1, At, B1); PG8_BAR;
            }
        }
        if constexpr (ALIGN_EPI) { if (wr == 0) PG8_BAR; }
        if constexpr (!Epi::AFTER_DRAIN) { E(acc, cur, wr, wc, fr, fq); S.done(cur); }
        if (!has_next) break;
#pragma unroll
        for (int a = 0; a < 2; ++a)
#pragma unroll
            for (int b = 0; b < 2; ++b)
#pragma unroll
                for (int m = 0; m < 4; ++m)
#pragma unroll
                    for (int n = 0; n < 2; ++n) acc[a][b][m][n] = (f32x4){0.f, 0.f, 0.f, 0.f};
        cur = nxt; cA = nA; cB = nB; ++ui;
        if constexpr (ALIGN_EPI) { if (wr == 1) PG8_BAR; }
    }
    PG8_WAIT_V(0);
    if constexpr (!ALIGN_EPI) { if (wr == 0) PG8_BAR; }
    PG8_BAR;
    if constexpr (Epi::AFTER_DRAIN) { E.fused(acc, cur, wr, wc, fr, fq, lds, wid, lane); S.done(cur); }
    E.tail(acc, cur, wr, wc, fr, fq);
#undef PG8_SA
#undef PG8_SB
#undef PG8_STAGE
#undef PG8_LDA
#undef PG8_LDB
#undef PG8_MMA
#undef PG8_WAIT_V
#undef PG8_WAIT_L
#undef PG8_BAR
#undef PG8_SCHED
}
}

namespace cg = cooperative_groups;
using pg8::bf16_t; using pg8::f32x4; using pg8::u32x4; using pg8::Unit;
typedef unsigned u32x2 __attribute__((ext_vector_type(2)));
typedef float f32x2 __attribute__((ext_vector_type(2)));

constexpr int DM = 1024, SEQ = 8192, NBATCH = 2, CTXL = 256, DFF = 2816;
constexpr int MLAT = NBATCH * SEQ;
constexpr int MCTX = NBATCH * CTXL;
constexpr int MTOT = MLAT + MCTX;
constexpr int PN_LD = 1536;
constexpr float LOG2E = 1.4426950408889634f;
constexpr float NORM_EPS = 1e-6f;
constexpr int NCHUNK = 66;

constexpr size_t MiB = 1u << 20;
constexpr size_t OFF_BAR = 0;
constexpr size_t OFF_MOD = 1 * MiB;
constexpr size_t OFF_ROPE = 1 * MiB + 256 * 1024;
constexpr size_t OFF_TW = 1 * MiB + 320 * 1024;
constexpr size_t OFF_LG = 1 * MiB + 400 * 1024;
constexpr size_t OFF_HC = 2 * MiB;
constexpr size_t OFF_WFFIN = 4 * MiB;  constexpr size_t SZ_WFFIN = (size_t)2 * DFF * DM * 2;
constexpr size_t OFF_WFFOUT = 48 * MiB; constexpr size_t SZ_WFFOUT = (size_t)DM * DFF * 2;
constexpr size_t OFF_WO = 70 * MiB;    constexpr size_t SZ_WO = (size_t)DM * DM * 2;
constexpr size_t OFF_R = 74 * MiB;
constexpr int R_XN_ROWS = MTOT, R_LAYER_ROWS = 2560, R_N_ROWS = 1536;
constexpr size_t OFF_BIG = 118 * MiB;
constexpr size_t OFF_ACT = OFF_BIG;
constexpr size_t OFF_PN = OFF_BIG;
constexpr size_t OFF_GT = OFF_BIG + 50 * MiB;
constexpr size_t OFF_VT = OFF_BIG + 84 * MiB;
constexpr size_t OFF_YCAT = OFF_BIG + 101 * MiB;
constexpr size_t OFF_KV = OFF_BIG + 135 * MiB;
constexpr size_t OFF_XBUF = OFF_BIG + 152 * MiB;
constexpr size_t WS_NEED = OFF_BIG + 154 * MiB;
constexpr int LDS_BYTES = 147456;

struct Params {
    const float *x, *c, *ctx, *c_ctx, *norm_w, *w_ada, *b_ada, *ffn_w_in, *ffn_w_out, *w_in, *w_o, *ret_decay, *ret_gn_w, *attn_sink, *final_norm_w;
    float* out; unsigned char* ws;
};

__device__ __forceinline__ unsigned pk2(float lo, float hi) { return pg8::cvt_pk_bf16(lo, hi); }
typedef __bf16 bf16x2_c __attribute__((ext_vector_type(2)));
__device__ __forceinline__ unsigned cvtpk_c(float lo, float hi) { f32x2 v = {lo, hi}; bf16x2_c b = __builtin_convertvector(v, bf16x2_c); return __builtin_bit_cast(unsigned, b); }
__device__ __forceinline__ u32x4 widen16(u32x2 wa, u32x2 wb) { const auto rx = __builtin_amdgcn_permlane16_swap(wa.x, wb.x, false, false); const auto ry = __builtin_amdgcn_permlane16_swap(wa.y, wb.y, false, false); return (u32x4){rx[0], ry[0], rx[1], ry[1]}; }
__device__ __forceinline__ float bf_lo(unsigned w) { return __builtin_bit_cast(float, w << 16); }
__device__ __forceinline__ float bf_hi(unsigned w) { return __builtin_bit_cast(float, w & 0xffff0000u); }
__device__ __forceinline__ float fexp2(float x) { return __builtin_amdgcn_exp2f(x); }
__device__ __forceinline__ float frcp(float x) { return __builtin_amdgcn_rcpf(x); }
__device__ __forceinline__ float silu_f(float g) { return g * frcp(1.0f + fexp2(-g * LOG2E)); }
__device__ __forceinline__ float wave_sum(float v) {
#pragma unroll
    for (int o = 1; o < 64; o <<= 1) v += __shfl_xor(v, o);
    return v;
}
__device__ __forceinline__ float log2_sigmoid(float x) { const float ls = x >= 0.f ? -log1pf(expf(-x)) : x - log1pf(expf(x)); return ls * LOG2E; }

struct EpiSwiglu {
    static constexpr bool PERM = false, AFTER_DRAIN = false;
    bf16_t* O;
    __device__ __forceinline__ void operator()(const f32x4 (&acc)[2][2][4][2], const Unit& u, int wr, int wc, int fr, int fq) const {
        const int row0 = u.pm * 256 + wr * 64 + fr, col0 = u.pn * 128 + wc * 16 + 4 * (fq & ~1);
#pragma unroll
        for (int ai = 0; ai < 2; ++ai)
#pragma unroll
            for (int mp = 0; mp < 2; ++mp) { bf16_t* rowp = O + (size_t)(row0 + ai * 128 + (2 * mp + (fq & 1)) * 16) * DFF + col0;
#pragma unroll
                for (int bj = 0; bj < 2; ++bj) {
                    const f32x4 g0 = acc[ai][bj][2 * mp][0], u0 = acc[ai][bj][2 * mp][1], g1 = acc[ai][bj][2 * mp + 1][0], u1 = acc[ai][bj][2 * mp + 1][1];
                    const unsigned ax = cvtpk_c(silu_f(g0[0]) * u0[0], silu_f(g0[1]) * u0[1]), ay = cvtpk_c(silu_f(g0[2]) * u0[2], silu_f(g0[3]) * u0[3]);
                    const unsigned bx = cvtpk_c(silu_f(g1[0]) * u1[0], silu_f(g1[1]) * u1[1]), by = cvtpk_c(silu_f(g1[2]) * u1[2], silu_f(g1[3]) * u1[3]);
                    const auto rx = __builtin_amdgcn_permlane16_swap(ax, bx, false, false); const auto ry = __builtin_amdgcn_permlane16_swap(ay, by, false, false);
                    *(u32x4*)(rowp + bj * 64) = (u32x4){rx[0], ry[0], rx[1], ry[1]}; }
                asm volatile("" ::: "memory"); }
    }
};
struct EpiResid {
    static constexpr bool PERM = false, AFTER_DRAIN = false;
    const float* src_lat; const float* src_ctx; float* dst_lat; float* dst_ctx; const float* modv; float sc;
    __device__ __forceinline__ void operator()(const f32x4 (&acc)[2][2][4][2], const Unit& u, int wr, int wc, int fr, int fq) const {
        const int set = u.pm < 32 ? 0 : (u.pm < 64 ? 1 : 2);
        const float* mv = modv + (size_t)set * 9 * DM;
        const bool lat = u.pm < 64;
        const int rbase = lat ? u.pm * 256 : u.pm * 256 - MLAT;
        const float* src = lat ? src_lat : src_ctx; float* dst = lat ? dst_lat : dst_ctx;
        const int col0 = u.pn * 256 + wc * 32 + 4 * fq;
        f32x4 mvv[2][2];
#pragma unroll
        for (int bj = 0; bj < 2; ++bj)
#pragma unroll
            for (int n = 0; n < 2; ++n) mvv[bj][n] = *(const f32x4*)(mv + col0 + bj * 128 + n * 16) * sc;
#pragma unroll
        for (int ai = 0; ai < 2; ++ai)
#pragma unroll
            for (int m = 0; m < 4; ++m) { const size_t off = (size_t)(rbase + ai * 128 + wr * 64 + m * 16 + fr) * DM + col0;
#pragma unroll
                for (int bj = 0; bj < 2; ++bj)
#pragma unroll
                    for (int n = 0; n < 2; ++n) { const f32x4 s = *(const f32x4*)(src + off + bj * 128 + n * 16);
                        *(f32x4*)(dst + off + bj * 128 + n * 16) = s + mvv[bj][n] * acc[ai][bj][m][n]; }
                if (m == 3) asm volatile("" ::: "memory"); }
    }
};
__device__ __forceinline__ void epi_resid_norm(f32x4 (&acc)[2][2][4][2], const Unit& u, int wr, int wc, int fr, int fq,
        const float* src_lat, const float* src_ctx, float* dst_lat, float* dst_ctx, const float* modv, float sc,
        const float* nw, const float* mshift, const float* mscale, bf16_t* XN, float* xbuf, unsigned* cnt, LAS unsigned char* xl, const float* fw) {
    {
        const int set = u.pm < 32 ? 0 : (u.pm < 64 ? 1 : 2);
        const float* mv = modv + (size_t)set * 9 * DM;
        const bool lat = u.pm < 64;
        const int rbase = lat ? u.pm * 256 : u.pm * 256 - MLAT;
        const float* src = lat ? src_lat : src_ctx; float* dst = lat ? dst_lat : dst_ctx;
        const int col0 = u.pn * 256 + wc * 32 + 4 * fq;
        LAS float* P = (LAS float*)xl; LAS float* S = (LAS float*)(xl + 4096);
        {   f32x4 mvv[2][2];
#pragma unroll
            for (int bj = 0; bj < 2; ++bj)
#pragma unroll
                for (int n = 0; n < 2; ++n) mvv[bj][n] = *(const f32x4*)(mv + col0 + bj * 128 + n * 16) * sc;
#pragma unroll
            for (int ai = 0; ai < 2; ++ai)
#pragma unroll
                for (int m = 0; m < 4; ++m) { const size_t off = (size_t)(rbase + ai * 128 + wr * 64 + m * 16 + fr) * DM + col0; float q = 0.f;
#pragma unroll
                    for (int bj = 0; bj < 2; ++bj)
#pragma unroll
                        for (int n = 0; n < 2; ++n) { const f32x4 s = *(const f32x4*)(src + off + bj * 128 + n * 16); const f32x4 v = s + mvv[bj][n] * acc[ai][bj][m][n];
                            if (fw == nullptr) *(f32x4*)(dst + off + bj * 128 + n * 16) = v;
                            acc[ai][bj][m][n] = v; q += (v[0] * v[0] + v[1] * v[1]) + (v[2] * v[2] + v[3] * v[3]); }
                    q += __shfl_xor(q, 16); q += __shfl_xor(q, 32);
                    if (fq == 0) P[(ai * 128 + wr * 64 + m * 16 + fr) * 4 + wc] = q;
                    if (m & 1) asm volatile("" ::: "memory"); }
        }
        asm volatile("s_waitcnt lgkmcnt(0)" ::: "memory"); __builtin_amdgcn_s_barrier(); asm volatile("" ::: "memory");
        const int tid = tidx(), lane = tid & 63, wid = tid >> 6, row = wid * 32 + (lane & 31);
        if (lane < 32) { const f32x4 p = *(const LAS f32x4*)(P + row * 4);
            __hip_atomic_store(xbuf + (size_t)(u.pm * 256 + row) * 4 + u.pn, (p[0] + p[1]) + (p[2] + p[3]), __ATOMIC_RELAXED, __HIP_MEMORY_SCOPE_AGENT); }
        asm volatile("s_waitcnt vmcnt(0)" ::: "memory");
        if (lane == 0) __hip_atomic_fetch_add(cnt + 64 * u.pm, 1u, __ATOMIC_RELAXED, __HIP_MEMORY_SCOPE_AGENT);
        if (wid == 0) { unsigned sp = 0;
            while ((unsigned)__builtin_amdgcn_readfirstlane(__hip_atomic_load(cnt + 64 * u.pm, __ATOMIC_RELAXED, __HIP_MEMORY_SCOPE_AGENT)) < 32u) { __builtin_amdgcn_s_sleep(2); if (++sp > (1u << 22)) break; }
            __builtin_amdgcn_fence(__ATOMIC_ACQUIRE, "agent"); }
        asm volatile("s_waitcnt vmcnt(0) lgkmcnt(0)" ::: "memory"); __builtin_amdgcn_s_barrier(); asm volatile("" ::: "memory");
        if (lane < 32) { const float* sl = xbuf + (size_t)(u.pm * 256 + row) * 4; float t = 0.f;
#pragma unroll
            for (int k = 0; k < 4; ++k) t += __hip_atomic_load(sl + k, __ATOMIC_RELAXED, __HIP_MEMORY_SCOPE_AGENT);
            S[row] = 1.0f / sqrtf(t * (1.0f / DM) + NORM_EPS); }
        asm volatile("s_waitcnt lgkmcnt(0)" ::: "memory"); __builtin_amdgcn_s_barrier(); asm volatile("" ::: "memory");
        const float* shp = mshift + (size_t)set * 9 * DM + col0; const float* scp = mscale + (size_t)set * 9 * DM + col0; const float* nwp = nw + col0;
#pragma unroll
        for (int ai = 0; ai < 2; ++ai)
#pragma unroll
            for (int mp = 0; mp < 2; ++mp) { const int rl0 = ai * 128 + wr * 64 + (2 * mp) * 16 + fr; const float rstd0 = S[rl0], rstd1 = S[rl0 + 16];
                if (fw != nullptr) {
#pragma unroll
                    for (int mo = 0; mo < 2; ++mo)
#pragma unroll
                        for (int bj = 0; bj < 2; ++bj)
#pragma unroll
                            for (int n = 0; n < 2; ++n) { const int co = bj * 128 + n * 16;
                                *(f32x4*)(dst + (size_t)(rbase + rl0 + 16 * mo) * DM + col0 + co) = acc[ai][bj][2 * mp + mo][n] * (mo ? rstd1 : rstd0) * *(const f32x4*)(fw + col0 + co); }
                } else {
                    bf16_t* xo = XN + (size_t)(u.pm * 256 + rl0 + (fq & 1) * 16) * DM + u.pn * 256 + wc * 32 + 4 * (fq & ~1);
#pragma unroll
                    for (int bj = 0; bj < 2; ++bj)
#pragma unroll
                        for (int n = 0; n < 2; ++n) { const int co = bj * 128 + n * 16;
                            const f32x4 gg = *(const f32x4*)(nwp + co) * (*(const f32x4*)(scp + co) + 1.0f); const f32x4 sh = *(const f32x4*)(shp + co);
                            const f32x4 y0 = acc[ai][bj][2 * mp][n] * rstd0 * gg + sh, y1 = acc[ai][bj][2 * mp + 1][n] * rstd1 * gg + sh;
                            *(u32x4*)(xo + co) = widen16((u32x2){cvtpk_c(y0[0], y0[1]), cvtpk_c(y0[2], y0[3])}, (u32x2){cvtpk_c(y1[0], y1[1]), cvtpk_c(y1[2], y1[3])}); }
                }
                asm volatile("" ::: "memory"); }
    }
}
struct EpiInProj {
    static constexpr bool PERM = false, AFTER_DRAIN = false;
    bf16_t* PN; float* GT; bf16_t* VT; const float* rope; int ntile0, ttile0;
    __device__ __forceinline__ void operator()(const f32x4 (&acc)[2][2][4][2], const Unit& u, int wr, int wc, int fr, int fq) const {
        if (u.pm < 66) {
            const int j = u.pn - ntile0;
            const bool do_rope = (j != 2) && (u.pm < 64);
            const float scl = (j == 1) ? 0.125f : ((j == 3 || j == 4) ? 0.125f * LOG2E : 1.0f);
#pragma unroll
            for (int ai = 0; ai < 2; ++ai)
#pragma unroll
                for (int mp = 0; mp < 2; ++mp) {
                    u32x2 w1[2][2], w2[2][2];
#pragma unroll
                    for (int mo = 0; mo < 2; ++mo) { const int m = 2 * mp + mo;
                        const int r = u.pm * 256 + ai * 128 + wr * 64 + m * 16 + fr;
                        f32x4 ca = {1.f, 0.f, 1.f, 0.f}, cb = {1.f, 0.f, 1.f, 0.f};
                        if (do_rope) { const int t = r & (SEQ - 1); const int pos = (wc & 1) ? (t & 63) : (t >> 6);
                            const float* rp = rope + (size_t)(pos * 16 + 4 * fq) * 2; ca = *(const f32x4*)rp; cb = *(const f32x4*)(rp + 4); }
#pragma unroll
                        for (int bj = 0; bj < 2; ++bj) { const f32x4 x1 = acc[ai][bj][m][0], x2 = acc[ai][bj][m][1];
                            f32x4 o1, o2;
                            o1[0] = x1[0] * ca[0] - x2[0] * ca[1]; o2[0] = x2[0] * ca[0] + x1[0] * ca[1];
                            o1[1] = x1[1] * ca[2] - x2[1] * ca[3]; o2[1] = x2[1] * ca[2] + x1[1] * ca[3];
                            o1[2] = x1[2] * cb[0] - x2[2] * cb[1]; o2[2] = x2[2] * cb[0] + x1[2] * cb[1];
                            o1[3] = x1[3] * cb[2] - x2[3] * cb[3]; o2[3] = x2[3] * cb[2] + x1[3] * cb[3];
                            o1 = o1 * scl; o2 = o2 * scl;
                            w1[mo][bj] = (u32x2){cvtpk_c(o1[0], o1[1]), cvtpk_c(o1[2], o1[3])}; w2[mo][bj] = (u32x2){cvtpk_c(o2[0], o2[1]), cvtpk_c(o2[2], o2[3])}; } }
                    bf16_t* rowp = PN + (size_t)(u.pm * 256 + ai * 128 + wr * 64 + (2 * mp + (fq & 1)) * 16 + fr) * PN_LD + j * 256 + wc * 32 + 4 * (fq & ~1);
#pragma unroll
                    for (int bj = 0; bj < 2; ++bj) { if (j == 5 && bj == 1) continue;
                        *(u32x4*)(rowp + bj * 128) = widen16(w1[0][bj], w1[1][bj]); *(u32x4*)(rowp + bj * 128 + 16) = widen16(w2[0][bj], w2[1][bj]); }
                    asm volatile("" ::: "memory");
                }
        } else {
            const int jt = u.pm - ttile0;
            const int tok0 = u.pn * 256 + wc * 32 + 4 * fq;
#pragma unroll
            for (int ai = 0; ai < 2; ++ai)
#pragma unroll
                for (int m = 0; m < 4; ++m) {
                    const int f = jt * 256 + ai * 128 + wr * 64 + m * 16 + fr;
                    if (jt < 2) { float* rowp = GT + (size_t)f * MTOT + tok0;
                        const int bin = 16 * m + fr;
                        const bool need = (wr == 0) ? (bin <= 32) : (bin >= 1 && bin <= 31);
                        if (need) {
#pragma unroll
                        for (int bj = 0; bj < 2; ++bj)
#pragma unroll
                            for (int n = 0; n < 2; ++n) *(f32x4*)(rowp + bj * 128 + n * 16) = acc[ai][bj][m][n]; }
                    } else if ((m & 1) == 0 && !(jt == 3 && ai == 1)) {
                        bf16_t* rowp = VT + (size_t)(f + (fq & 1) * 16 - 512) * MTOT + u.pn * 256 + wc * 32 + 4 * (fq & ~1);
#pragma unroll
                        for (int bj = 0; bj < 2; ++bj)
#pragma unroll
                            for (int n = 0; n < 2; ++n) { const f32x4 va = acc[ai][bj][m][n], vb = acc[ai][bj][m + 1][n];
                                *(u32x4*)(rowp + bj * 128 + n * 16) = widen16((u32x2){cvtpk_c(va[0], va[1]), cvtpk_c(va[2], va[3])}, (u32x2){cvtpk_c(vb[0], vb[1]), cvtpk_c(vb[2], vb[3])}); }
                    }
                }
        }
    }
};
struct InSched {
    int G, c, ntile0, ttile0;
    __device__ __forceinline__ bool next(int i, Unit& u) const {
        int tok, j;
        if (G == 256) { const int x = c & 7, n = i * 32 + (c >> 3), k = n / 10; tok = x + 8 * k; j = n - 10 * k; if (tok >= 66) return false; }
        else { const int L = i * G + c; if (L >= 660) return false; tok = L / 10; j = L % 10; }
        if (j < 6) { u.pm = tok; u.pn = ntile0 + j; } else { u.pm = ttile0 + (j - 6); u.pn = tok; }
        return true;
    }
    __device__ __forceinline__ void a_ready(const Unit&) const {}
    __device__ __forceinline__ void done(const Unit&) const {}
};

__device__ __forceinline__ bf16_t* dest_rowptr(int kind, int idx, int n, unsigned char* ws) {
    if (kind == 0) { const int half = n >= DFF ? 1 : 0; const int jj = n - half * DFF; const int row = 32 * (jj >> 4) + 16 * half + (jj & 15);
        return (bf16_t*)(ws + OFF_WFFIN + (size_t)idx * SZ_WFFIN) + (size_t)row * DM; }
    if (kind == 1) return (bf16_t*)(ws + OFF_WFFOUT + (size_t)idx * SZ_WFFOUT) + (size_t)n * DFF;
    if (kind == 2) return (bf16_t*)(ws + OFF_WO + (size_t)idx * SZ_WO) + (size_t)n * DM;
    const int rn = R_XN_ROWS + R_LAYER_ROWS * idx, rt = rn + R_N_ROWS; int row;
    if (n < 512) row = rn + (n - 256);
    else if (n < 768) row = rn + 256 + (n - 512);
    else if (n < 1024) row = rt + 512 + (n - 768);
    else if (n < 1280) row = rn + 512 + (n - 1024);
    else if (n < 1792) row = rn + 768 + (n - 1280);
    else if (n < 1920) row = rn + 1280 + (n - 1792);
    else row = rt + 768 + (n - 1920);
    return (bf16_t*)(ws + OFF_R) + (size_t)row * DM;
}
__device__ __forceinline__ void transpose_item(const float* W, int N, int k0, int n0, int kind, int idx, unsigned char* ws, LAS float* scr, int lane) {
    const int ks = lane >> 4, n4 = (lane & 15) * 4;
#pragma unroll 8
    for (int i = 0; i < 16; ++i) { const int kk = 4 * i + ks; const f32x4 v = __builtin_nontemporal_load((const f32x4*)(W + (size_t)(k0 + kk) * N + n0 + n4));
        LAS float* d = scr + kk * 65 + n4; d[0] = v[0]; d[1] = v[1]; d[2] = v[2]; d[3] = v[3]; }
    asm volatile("s_waitcnt lgkmcnt(0)" ::: "memory");
    const int c = lane & 7;
    const bool kperm = (kind == 2) && (k0 < 256);
#pragma unroll
    for (int j = 0; j < 8; ++j) { const int n = (lane >> 3) + 8 * j; const LAS float* s = scr + n;
        int kk[8];
#pragma unroll
        for (int e = 0; e < 8; ++e) { const int q = 8 * c + e; kk[e] = kperm ? (q == 0 ? 0 : (q == 1 ? 32 : ((q & 1) ? 64 - (q >> 1) : (q >> 1)))) : q; }
        u32x4 o; o.x = pk2(s[kk[0] * 65], s[kk[1] * 65]); o.y = pk2(s[kk[2] * 65], s[kk[3] * 65]); o.z = pk2(s[kk[4] * 65], s[kk[5] * 65]); o.w = pk2(s[kk[6] * 65], s[kk[7] * 65]);
        *(u32x4*)(dest_rowptr(kind, idx, n0 + n, ws) + k0 + 8 * c) = o; }
    asm volatile("s_waitcnt lgkmcnt(0)" ::: "memory");
}

template <class PP> __device__ __forceinline__ void p0_prologue(const PP& P, LAS unsigned char* lds) {
    const int tid = tidx(), lane = tid & 63, wave = __builtin_amdgcn_readfirstlane(tid >> 6);
    const int G = gdim(), bx = bidx();
    unsigned char* ws = P.ws;
    __syncthreads();
    LAS float* cond_s = (LAS float*)(lds + 73728);
    LAS float* red = (LAS float*)(lds + 86016);
    LAS f32x2* cs64 = (LAS f32x2*)(lds + 110592);
    for (int i = tid; i < 3 * DM; i += 512) { const int s = i >> 10, k = i & 1023; const float v = s < 2 ? P.c[s * DM + k] : P.c_ctx[k]; cond_s[i] = v / (1.0f + expf(-v)); }
    if (tid < 64) { float sn, cn; sincospif((float)tid / 32.0f, &sn, &cn); cs64[tid] = (f32x2){cn, sn}; }
    __syncthreads();
    float* MOD = (float*)(ws + OFF_MOD);
    for (int item = bx; item < 144; item += G) {
        const int L = item / 72, n0 = (item % 72) * 128;
        const float* W = P.w_ada + (size_t)L * DM * 9216 + n0 + 2 * lane;
        f32x2 a0 = {0.f, 0.f}, a1 = a0, a2 = a0;
#pragma unroll 8
        for (int kk = 0; kk < 128; ++kk) { const int k = wave * 128 + kk; const f32x2 w = __builtin_nontemporal_load((const f32x2*)(W + (size_t)k * 9216)); a0 += w * cond_s[k]; a1 += w * cond_s[1024 + k]; a2 += w * cond_s[2048 + k]; }
        *(LAS f32x2*)(red + (wave * 3 + 0) * 128 + 2 * lane) = a0; *(LAS f32x2*)(red + (wave * 3 + 1) * 128 + 2 * lane) = a1; *(LAS f32x2*)(red + (wave * 3 + 2) * 128 + 2 * lane) = a2;
        __syncthreads();
        if (tid < 384) { const int s = tid >> 7, l = tid & 127; float t = P.b_ada[L * 9216 + n0 + l];
#pragma unroll
            for (int w = 0; w < 8; ++w) t += red[(w * 3 + s) * 128 + l];
            MOD[(size_t)(L * 3 + s) * 9216 + n0 + l] = t; }
        __syncthreads();
    }
    for (int item = bx; item < 256; item += G) {
        const int L = item >> 7, g = (item >> 5) & 3, k = ((item >> 4) & 1) * 512 + tid, m0 = (item & 15) * 4;
        const float* wrow = P.w_in + ((size_t)L * DM + k) * 2048 + g * 64;
        float w[64];
#pragma unroll
        for (int c4 = 0; c4 < 16; ++c4) { const f32x4 v = *(const f32x4*)(wrow + 4 * c4); w[4 * c4] = v[0]; w[4 * c4 + 1] = v[1]; w[4 * c4 + 2] = v[2]; w[4 * c4 + 3] = v[3]; }
        bf16_t* Rb = (bf16_t*)(ws + OFF_R) + (size_t)(R_XN_ROWS + R_LAYER_ROWS * L + R_N_ROWS + g * 128) * DM + k;
        for (int m = m0; m < m0 + 4; ++m) {
            float re = 0.f, im = 0.f;
#pragma unroll
            for (int c = 0; c < 64; ++c) { const f32x2 t = cs64[(m * c) & 63]; re += w[c] * t.x; im -= w[c] * t.y; }
            Rb[(size_t)m * DM] = (bf16_t)(pk2(re, 0.f) & 0xffffu); Rb[(size_t)(64 + m) * DM] = (bf16_t)(pk2(im, 0.f) & 0xffffu);
        }
    }
    __syncthreads();
    {
        LAS float* scr = (LAS float*)(lds + wave * 16640);
        const int gw = bx * 8 + wave, NGW = G * 8;
        constexpr int I0 = 4 * 16 * 88, I1 = 4 * 44 * 16, I2 = 2 * 16 * 16, I3 = 2 * 16 * 28;
        for (int it = gw; it < I0 + I1 + I2 + I3; it += NGW) {
            int r = it;
            if (r < I0) { const int idx = r / (16 * 88), q = r % (16 * 88); transpose_item(P.ffn_w_in + (size_t)idx * DM * 2 * DFF, 2 * DFF, (q / 88) * 64, (q % 88) * 64, 0, idx, ws, scr, lane); continue; } r -= I0;
            if (r < I1) { const int idx = r / (44 * 16), q = r % (44 * 16); transpose_item(P.ffn_w_out + (size_t)idx * DFF * DM, DM, (q / 16) * 64, (q % 16) * 64, 1, idx, ws, scr, lane); continue; } r -= I1;
            if (r < I2) { const int idx = r / (16 * 16), q = r % (16 * 16); transpose_item(P.w_o + (size_t)idx * DM * DM, DM, (q / 16) * 64, (q % 16) * 64, 2, idx, ws, scr, lane); continue; } r -= I2;
            { const int idx = r / (16 * 28), q = r % (16 * 28); transpose_item(P.w_in + (size_t)idx * DM * 2048, 2048, (q / 28) * 64, (4 + q % 28) * 64, 3, idx, ws, scr, lane); }
        }
    }
    {
        const int gt = bx * 512 + tid, NGT = G * 512;
        f32x2* rope = (f32x2*)(ws + OFF_ROPE); f32x2* tw = (f32x2*)(ws + OFF_TW);
        if (gt < 16) ((float*)(ws + OFF_LG))[gt] = log2_sigmoid(P.ret_decay[gt]);
        for (int i = gt; i < 2048; i += NGT) { const int pos = i >> 4, p = i & 15; const float inv = exp2f(-(float)p * (13.287712379549449f / 16.0f)); const float ang = (float)pos * inv; float sn, cn; sincosf(ang, &sn, &cn); rope[i] = (f32x2){cn, sn}; }
        for (int i = gt; i < 8191; i += NGT) { int st = 0; while (i >= 8192 - (8192 >> (st + 1))) ++st; const int j = i - (8192 - (8192 >> st));
            float sn, cn; sincospif((float)(j << st) / 4096.0f, &sn, &cn); tw[i] = (f32x2){cn, -sn}; }
        for (int i = gt; i < 2 * 32768; i += NGT) { const int L = i >> 15, q = i & 32767, rr = q >> 7, piece = q & 127;
            const int row = R_XN_ROWS + R_LAYER_ROWS * L + (rr < 128 ? 1408 + rr : R_N_ROWS + 896 + (rr - 128));
            unsigned zz = 0u; asm volatile("" : "+v"(zz));
            *(u32x4*)((bf16_t*)(ws + OFF_R) + (size_t)row * DM + piece * 8) = (u32x4){zz, zz, zz, zz}; }
    }
}

__device__ __forceinline__ void norm_phase(const float* src_lat, const float* src_ctx, const float* nw, const float* mod_shift, const float* mod_scale, bf16_t* XN, int nrows) {
    const int tid = tidx(), lane = tid & 63, wave = tid >> 6;
    const int gw = bidx() * 8 + wave, NGW = gdim() * 8;
    f32x4 wv[4];
#pragma unroll
    for (int j = 0; j < 4; ++j) wv[j] = *(const f32x4*)(nw + 4 * lane + 256 * j);
    for (int r = gw; r < nrows; r += NGW) {
        const float* xr = r < MLAT ? src_lat + (size_t)r * DM : src_ctx + (size_t)(r - MLAT) * DM;
        const int set = r < SEQ ? 0 : (r < MLAT ? 1 : 2);
        f32x4 v[4]; float s = 0.f;
#pragma unroll
        for (int j = 0; j < 4; ++j) { v[j] = *(const f32x4*)(xr + 4 * lane + 256 * j); s += (v[j][0] * v[j][0] + v[j][1] * v[j][1]) + (v[j][2] * v[j][2] + v[j][3] * v[j][3]); }
        const float rstd = 1.0f / sqrtf(wave_sum(s) * (1.0f / DM) + NORM_EPS);
        bf16_t* orow = XN + (size_t)r * DM;
#pragma unroll
        for (int j = 0; j < 4; ++j) { const f32x4 sh = *(const f32x4*)(mod_shift + (size_t)set * 9 * DM + 4 * lane + 256 * j), sc = *(const f32x4*)(mod_scale + (size_t)set * 9 * DM + 4 * lane + 256 * j);
            const f32x4 y = v[j] * rstd * wv[j] * (sc + 1.0f) + sh;
            u32x2 w; w.x = pk2(y[0], y[1]); w.y = pk2(y[2], y[3]); *(u32x2*)(orow + 4 * lane + 256 * j) = w; }
    }
}
__device__ __forceinline__ void norm_rows(const float* src_lat, const float* src_ctx, const float* nw, const float* mod_shift, const float* mod_scale, bf16_t* XN, int r0, int nr) {
    const int tid = tidx(), lane = tid & 63, wave = tid >> 6;
    f32x4 wv[4];
#pragma unroll
    for (int j = 0; j < 4; ++j) wv[j] = *(const f32x4*)(nw + 4 * lane + 256 * j);
    for (int r = r0 + wave; r < r0 + nr; r += 8) {
        const float* xr = r < MLAT ? src_lat + (size_t)r * DM : src_ctx + (size_t)(r - MLAT) * DM;
        const int set = r < SEQ ? 0 : (r < MLAT ? 1 : 2);
        f32x4 v[4]; float s = 0.f;
#pragma unroll
        for (int j = 0; j < 4; ++j) { v[j] = *(const f32x4*)(xr + 4 * lane + 256 * j); s += (v[j][0] * v[j][0] + v[j][1] * v[j][1]) + (v[j][2] * v[j][2] + v[j][3] * v[j][3]); }
        const float rstd = 1.0f / sqrtf(wave_sum(s) * (1.0f / DM) + NORM_EPS);
        bf16_t* orow = XN + (size_t)r * DM;
#pragma unroll
        for (int j = 0; j < 4; ++j) { const f32x4 sh = *(const f32x4*)(mod_shift + (size_t)set * 9 * DM + 4 * lane + 256 * j), sc = *(const f32x4*)(mod_scale + (size_t)set * 9 * DM + 4 * lane + 256 * j);
            const f32x4 y = v[j] * rstd * wv[j] * (sc + 1.0f) + sh;
            u32x2 w; w.x = pk2(y[0], y[1]); w.y = pk2(y[2], y[3]); *(u32x2*)(orow + 4 * lane + 256 * j) = w; }
    }
}
__device__ __forceinline__ void final_norm_rows(float* out, const float* fw, int r0, int nr) {
    const int tid = tidx(), lane = tid & 63, wave = tid >> 6;
    f32x4 wv[4];
#pragma unroll
    for (int j = 0; j < 4; ++j) wv[j] = *(const f32x4*)(fw + 4 * lane + 256 * j);
    for (int r = r0 + wave; r < r0 + nr; r += 8) {
        float* xr = out + (size_t)r * DM;
        f32x4 v[4]; float s = 0.f;
#pragma unroll
        for (int j = 0; j < 4; ++j) { v[j] = *(const f32x4*)(xr + 4 * lane + 256 * j); s += (v[j][0] * v[j][0] + v[j][1] * v[j][1]) + (v[j][2] * v[j][2] + v[j][3] * v[j][3]); }
        const float rstd = 1.0f / sqrtf(wave_sum(s) * (1.0f / DM) + NORM_EPS);
#pragma unroll
        for (int j = 0; j < 4; ++j) *(f32x4*)(xr + 4 * lane + 256 * j) = v[j] * rstd * wv[j];
    }
}
__device__ __forceinline__ void final_norm_phase(float* out, const float* fw) {
    const int tid = tidx(), lane = tid & 63, wave = tid >> 6;
    const int gw = bidx() * 8 + wave, NGW = gdim() * 8;
    f32x4 wv[4];
#pragma unroll
    for (int j = 0; j < 4; ++j) wv[j] = *(const f32x4*)(fw + 4 * lane + 256 * j);
    for (int r = gw; r < MLAT; r += NGW) {
        float* xr = out + (size_t)r * DM;
        f32x4 v[4]; float s = 0.f;
#pragma unroll
        for (int j = 0; j < 4; ++j) { v[j] = *(const f32x4*)(xr + 4 * lane + 256 * j); s += (v[j][0] * v[j][0] + v[j][1] * v[j][1]) + (v[j][2] * v[j][2] + v[j][3] * v[j][3]); }
        const float rstd = 1.0f / sqrtf(wave_sum(s) * (1.0f / DM) + NORM_EPS);
#pragma unroll
        for (int j = 0; j < 4; ++j) *(f32x4*)(xr + 4 * lane + 256 * j) = v[j] * rstd * wv[j];
    }
}

__device__ __forceinline__ int chunk_row0(int b, int c) { return c < 64 ? b * SEQ + 128 * c : MLAT + b * CTXL + 128 * (c - 64); }

__device__ __forceinline__ void stage_rows_f32(const bf16_t* src, int ld, LAS float* dst, int tid) {
    const int j = tid >> 2, d0 = (tid & 3) * 16;
    const u32x4 a = *(const u32x4*)(src + (size_t)j * ld + d0), b = *(const u32x4*)(src + (size_t)j * ld + d0 + 8);
    LAS f32x4* o = (LAS f32x4*)(dst + j * 64 + d0);
    o[0] = (f32x4){bf_lo(a.x), bf_hi(a.x), bf_lo(a.y), bf_hi(a.y)}; o[1] = (f32x4){bf_lo(a.z), bf_hi(a.z), bf_lo(a.w), bf_hi(a.w)};
    o[2] = (f32x4){bf_lo(b.x), bf_hi(b.x), bf_lo(b.y), bf_hi(b.y)}; o[3] = (f32x4){bf_lo(b.z), bf_hi(b.z), bf_lo(b.w), bf_hi(b.w)};
}
__device__ __forceinline__ void stage_cols_f32(const bf16_t* src, LAS float* dst, int tid) {
    const int d = tid >> 3, j0 = (tid & 7) * 16;
    const u32x4 a = *(const u32x4*)(src + (size_t)d * MTOT + j0), b = *(const u32x4*)(src + (size_t)d * MTOT + j0 + 8);
    LAS float* o = dst + j0 * 64 + d;
    o[0 * 64] = bf_lo(a.x); o[1 * 64] = bf_hi(a.x); o[2 * 64] = bf_lo(a.y); o[3 * 64] = bf_hi(a.y); o[4 * 64] = bf_lo(a.z); o[5 * 64] = bf_hi(a.z); o[6 * 64] = bf_lo(a.w); o[7 * 64] = bf_hi(a.w);
    o[8 * 64] = bf_lo(b.x); o[9 * 64] = bf_hi(b.x); o[10 * 64] = bf_lo(b.y); o[11 * 64] = bf_hi(b.y); o[12 * 64] = bf_lo(b.z); o[13 * 64] = bf_hi(b.z); o[14 * 64] = bf_lo(b.w); o[15 * 64] = bf_hi(b.w);
}

__device__ __forceinline__ void attn_unit(const bf16_t* PN, const bf16_t* VT, bf16_t* YC, const float* sink, LAS unsigned char* lds, int b, int kvh, int qt, bool isctx) {
    const int tid = tidx(), i = tid & 127, g = tid >> 7, head = kvh * 4 + g;
    LAS float* Ks = (LAS float*)lds; LAS float* Vs = (LAS float*)(lds + 32768);
    const int row0 = isctx ? MLAT + b * CTXL + 128 * qt : b * SEQ + 128 * qt;
    float q[64], o[64];
    { const bf16_t* qp = PN + (size_t)(row0 + i) * PN_LD + 768 + head * 64;
#pragma unroll
      for (int c8 = 0; c8 < 8; ++c8) { const u32x4 a = *(const u32x4*)(qp + 8 * c8);
          q[8 * c8] = bf_lo(a.x); q[8 * c8 + 1] = bf_hi(a.x); q[8 * c8 + 2] = bf_lo(a.y); q[8 * c8 + 3] = bf_hi(a.y); q[8 * c8 + 4] = bf_lo(a.z); q[8 * c8 + 5] = bf_hi(a.z); q[8 * c8 + 6] = bf_lo(a.w); q[8 * c8 + 7] = bf_hi(a.w); } }
#pragma unroll
    for (int d = 0; d < 64; ++d) o[d] = 0.f;
    float mx = sink[head] * LOG2E, l = 1.0f;
    for (int ch = 0; ch < 5; ++ch) {
        int krow0;
        if (ch < 3) { if (isctx) continue; const int kb = qt - 1 + ch; if (kb < 0 || kb >= 64) continue; krow0 = b * SEQ + 128 * kb; }
        else krow0 = MLAT + b * CTXL + 128 * (ch - 3);
        __syncthreads();
        stage_rows_f32(PN + (size_t)krow0 * PN_LD + 1280 + kvh * 64, PN_LD, Ks, tid);
        stage_cols_f32(VT + (size_t)(256 + kvh * 64) * MTOT + krow0, Vs, tid);
        __syncthreads();
        for (int j = 0; j < 128; ++j) {
            const bool valid = (ch == 0) ? (j >= i) : ((ch == 2) ? (j <= i) : true);
            if (valid) {
                const LAS f32x4* kr = (const LAS f32x4*)(Ks + j * 64);
                float s0 = 0.f, s1 = 0.f;
#pragma unroll
                for (int d4 = 0; d4 < 16; ++d4) { const f32x4 kv = kr[d4]; s0 += q[4 * d4] * kv[0] + q[4 * d4 + 2] * kv[2]; s1 += q[4 * d4 + 1] * kv[1] + q[4 * d4 + 3] * kv[3]; if ((d4 & 3) == 3) asm volatile("" ::: "memory"); }
                const float s = s0 + s1;
                if (s > mx) { const float a = fexp2(mx - s); l *= a;
#pragma unroll
                    for (int d = 0; d < 64; ++d) o[d] *= a;
                    mx = s; }
                const float p = fexp2(s - mx); l += p;
                const LAS f32x4* vr = (const LAS f32x4*)(Vs + j * 64);
#pragma unroll
                for (int d4 = 0; d4 < 16; ++d4) { const f32x4 vv = vr[d4]; o[4 * d4] += p * vv[0]; o[4 * d4 + 1] += p * vv[1]; o[4 * d4 + 2] += p * vv[2]; o[4 * d4 + 3] += p * vv[3]; if ((d4 & 3) == 3) asm volatile("" ::: "memory"); }
            }
        }
    }
    const float inv = 1.0f / l;
    bf16_t* op = YC + (size_t)(row0 + i) * DM + 512 + head * 64;
#pragma unroll
    for (int c8 = 0; c8 < 8; ++c8) { u32x4 w; w.x = pk2(o[8 * c8] * inv, o[8 * c8 + 1] * inv); w.y = pk2(o[8 * c8 + 2] * inv, o[8 * c8 + 3] * inv); w.z = pk2(o[8 * c8 + 4] * inv, o[8 * c8 + 5] * inv); w.w = pk2(o[8 * c8 + 6] * inv, o[8 * c8 + 7] * inv);
        *(u32x4*)(op + 8 * c8) = w; }
    __syncthreads();
}

__device__ __forceinline__ void ret_kv_unit(const bf16_t* PN, const bf16_t* VT, float* KV, const float* decay  , LAS unsigned char* lds, int b, int h, int c) {
    const int tid = tidx();
    LAS float* Ks = (LAS float*)lds; LAS float* Vs = (LAS float*)(lds + 32768); LAS f32x2* wt = (LAS f32x2*)(lds + 65536);
    const int row0 = chunk_row0(b, c);
    __syncthreads();
    stage_rows_f32(PN + (size_t)row0 * PN_LD + 256 + h * 64, PN_LD, Ks, tid);
    stage_cols_f32(VT + (size_t)(h * 64) * MTOT + row0, Vs, tid);
    if (tid < 128) { const float lg0 = decay[h], lg1 = decay[4 + h]; wt[tid] = (f32x2){fexp2(lg0 * (float)(127 - tid)), fexp2(lg1 * (float)tid)}; }
    __syncthreads();
    const int a = tid & 63, b0 = (tid >> 6) * 8;
    float acc0[8], acc1[8];
#pragma unroll
    for (int e = 0; e < 8; ++e) { acc0[e] = 0.f; acc1[e] = 0.f; }
#pragma unroll 4
    for (int p = 0; p < 128; ++p) {
        const float k = Ks[p * 64 + a]; const f32x2 w = wt[p]; const float k0 = k * w.x, k1 = k * w.y;
        const f32x4 va = *(const LAS f32x4*)(Vs + p * 64 + b0), vb = *(const LAS f32x4*)(Vs + p * 64 + b0 + 4);
        acc0[0] += k0 * va[0]; acc0[1] += k0 * va[1]; acc0[2] += k0 * va[2]; acc0[3] += k0 * va[3]; acc0[4] += k0 * vb[0]; acc0[5] += k0 * vb[1]; acc0[6] += k0 * vb[2]; acc0[7] += k0 * vb[3];
        acc1[0] += k1 * va[0]; acc1[1] += k1 * va[1]; acc1[2] += k1 * va[2]; acc1[3] += k1 * va[3]; acc1[4] += k1 * vb[0]; acc1[5] += k1 * vb[1]; acc1[6] += k1 * vb[2]; acc1[7] += k1 * vb[3];
    }
    float* o0 = KV + ((size_t)((0 * 2 + b) * 4 + h) * NCHUNK + c) * 4096 + a;
    float* o1 = KV + ((size_t)((1 * 2 + b) * 4 + h) * NCHUNK + c) * 4096 + a;
#pragma unroll
    for (int e = 0; e < 8; ++e) { o0[(b0 + e) * 64] = acc0[e]; o1[(b0 + e) * 64] = acc1[e]; }
}

__device__ __forceinline__ void ret_scan_unit(float* KV, const float* decay, int unit) {
    const int e = unit * 512 + tidx(), seq = e >> 12, idx = e & 4095, dir = seq >> 3, h = seq & 3;
    const float Gd = fexp2(decay[dir * 4 + h] * 128.0f);
    float* base = KV + (size_t)seq * NCHUNK * 4096 + idx;
    float v[NCHUNK];
#pragma unroll
    for (int st = 0; st < NCHUNK; ++st) { const int c = (dir == 0) ? (st < 2 ? 64 + st : st - 2) : 65 - st; v[st] = base[(size_t)c * 4096]; }
    float S = 0.f;
#pragma unroll
    for (int st = 0; st < NCHUNK; ++st) { const float kv = v[st]; v[st] = S; S = S * Gd + kv; }
#pragma unroll
    for (int st = 0; st < NCHUNK; ++st) { const int c = (dir == 0) ? (st < 2 ? 64 + st : st - 2) : 65 - st; base[(size_t)c * 4096] = v[st]; }
}

__device__ __forceinline__ void ret_out_unit(const bf16_t* PN, const bf16_t* VT, const float* KV, bf16_t* YC, const float* decay, const float* gnw  , LAS unsigned char* lds, int b, int h, int c) {
    const int tid = tidx(), p = tid & 127, dvq = tid >> 7;
    LAS float* Ks = (LAS float*)lds; LAS float* Vs = (LAS float*)(lds + 32768); LAS float* S0 = (LAS float*)(lds + 65536); LAS float* S1 = (LAS float*)(lds + 81920); LAS float* red = (LAS float*)(lds + 98304); LAS float* Qs = (LAS float*)(lds + 102400);
    const int row0 = chunk_row0(b, c);
    __syncthreads();
    stage_rows_f32(PN + (size_t)row0 * PN_LD + 256 + h * 64, PN_LD, Ks, tid);
    stage_cols_f32(VT + (size_t)(h * 64) * MTOT + row0, Vs, tid);
    { const float* s0 = KV + ((size_t)((0 * 2 + b) * 4 + h) * NCHUNK + c) * 4096 + tid * 8; const float* s1 = KV + ((size_t)((1 * 2 + b) * 4 + h) * NCHUNK + c) * 4096 + tid * 8;
      const f32x4 a0 = *(const f32x4*)s0, a1 = *(const f32x4*)(s0 + 4), b0 = *(const f32x4*)s1, b1 = *(const f32x4*)(s1 + 4);
      const int dv = tid >> 3, dk0 = (tid & 7) * 8;
#pragma unroll
      for (int e = 0; e < 4; ++e) { S0[(dk0 + e) * 64 + dv] = a0[e]; S0[(dk0 + 4 + e) * 64 + dv] = a1[e]; S1[(dk0 + e) * 64 + dv] = b0[e]; S1[(dk0 + 4 + e) * 64 + dv] = b1[e]; } }
    float q[64];
    { const bf16_t* qp = PN + (size_t)(row0 + p) * PN_LD + h * 64;
#pragma unroll
      for (int c8 = 0; c8 < 8; ++c8) { const u32x4 a = *(const u32x4*)(qp + 8 * c8);
          q[8 * c8] = bf_lo(a.x); q[8 * c8 + 1] = bf_hi(a.x); q[8 * c8 + 2] = bf_lo(a.y); q[8 * c8 + 3] = bf_hi(a.y); q[8 * c8 + 4] = bf_lo(a.z); q[8 * c8 + 5] = bf_hi(a.z); q[8 * c8 + 6] = bf_lo(a.w); q[8 * c8 + 7] = bf_hi(a.w); } }
    if (dvq == 0) {
#pragma unroll
        for (int d = 0; d < 64; ++d) Qs[p * 65 + d] = q[d]; }
    const float lg0 = decay[h], lg1 = decay[4 + h];
    __syncthreads();
    float out[16];
#pragma unroll
    for (int v = 0; v < 16; ++v) out[v] = 0.f;
    for (int pp = 0; pp < 128; ++pp) {
        const LAS f32x4* kr = (const LAS f32x4*)(Ks + pp * 64);
        float s0 = 0.f, s1 = 0.f;
#pragma unroll
        for (int d4 = 0; d4 < 16; ++d4) { const f32x4 kv = kr[d4]; s0 += q[4 * d4] * kv[0] + q[4 * d4 + 2] * kv[2]; s1 += q[4 * d4 + 1] * kv[1] + q[4 * d4 + 3] * kv[3]; if ((d4 & 3) == 3) asm volatile("" ::: "memory"); }
        const float df = (float)(p - pp);
        const float dec = df > 0.f ? fexp2(lg0 * df) : (df < 0.f ? fexp2(-lg1 * df) : 2.0f);
        const float s = (s0 + s1) * dec;
        const LAS f32x4* vr = (const LAS f32x4*)(Vs + pp * 64 + dvq * 16);
#pragma unroll
        for (int v4 = 0; v4 < 4; ++v4) { const f32x4 vv = vr[v4]; out[4 * v4] += s * vv[0]; out[4 * v4 + 1] += s * vv[1]; out[4 * v4 + 2] += s * vv[2]; out[4 * v4 + 3] += s * vv[3]; }
    }
    {
        float x0[16], x1[16];
#pragma unroll
        for (int v = 0; v < 16; ++v) { x0[v] = 0.f; x1[v] = 0.f; }
#pragma unroll 2
        for (int dk = 0; dk < 64; ++dk) {
            const float t = Qs[p * 65 + dk];
            const LAS f32x4* r0 = (const LAS f32x4*)(S0 + dk * 64 + dvq * 16); const LAS f32x4* r1 = (const LAS f32x4*)(S1 + dk * 64 + dvq * 16);
#pragma unroll
            for (int v4 = 0; v4 < 4; ++v4) { const f32x4 a = r0[v4], bb = r1[v4];
                x0[4 * v4] += t * a[0]; x0[4 * v4 + 1] += t * a[1]; x0[4 * v4 + 2] += t * a[2]; x0[4 * v4 + 3] += t * a[3];
                x1[4 * v4] += t * bb[0]; x1[4 * v4 + 1] += t * bb[1]; x1[4 * v4 + 2] += t * bb[2]; x1[4 * v4 + 3] += t * bb[3]; }
        }
        const float f0 = fexp2(lg0 * (float)(p + 1)), f1 = fexp2(lg1 * (float)(128 - p));
#pragma unroll
        for (int v = 0; v < 16; ++v) out[v] += x0[v] * f0 + x1[v] * f1;
    }
    float s = 0.f;
#pragma unroll
    for (int v = 0; v < 16; ++v) s += out[v];
    red[dvq * 128 + p] = s;
    __syncthreads();
    const float mu = (red[p] + red[128 + p] + red[256 + p] + red[384 + p]) * (1.0f / 64.0f);
    float qv = 0.f;
#pragma unroll
    for (int v = 0; v < 16; ++v) { const float d = out[v] - mu; qv += d * d; }
    red[512 + dvq * 128 + p] = qv;
    __syncthreads();
    const float var = (red[512 + p] + red[640 + p] + red[768 + p] + red[896 + p]) * (1.0f / 64.0f);
    const float rstd = 1.0f / sqrtf(var + NORM_EPS);
    const bf16_t* gp = PN + (size_t)(row0 + p) * PN_LD + 512 + h * 64 + dvq * 16;
    const u32x4 ga = *(const u32x4*)gp, gb = *(const u32x4*)(gp + 8);
    float gt[16] = {bf_lo(ga.x), bf_hi(ga.x), bf_lo(ga.y), bf_hi(ga.y), bf_lo(ga.z), bf_hi(ga.z), bf_lo(ga.w), bf_hi(ga.w), bf_lo(gb.x), bf_hi(gb.x), bf_lo(gb.y), bf_hi(gb.y), bf_lo(gb.z), bf_hi(gb.z), bf_lo(gb.w), bf_hi(gb.w)};
    float y[16];
#pragma unroll
    for (int v = 0; v < 16; ++v) y[v] = silu_f(gt[v]) * ((out[v] - mu) * rstd * gnw[h * 64 + dvq * 16 + v]);
    bf16_t* op = YC + (size_t)(row0 + p) * DM + 256 + h * 64 + dvq * 16;
    u32x4 w0, w1;
    w0.x = pk2(y[0], y[1]); w0.y = pk2(y[2], y[3]); w0.z = pk2(y[4], y[5]); w0.w = pk2(y[6], y[7]);
    w1.x = pk2(y[8], y[9]); w1.y = pk2(y[10], y[11]); w1.z = pk2(y[12], y[13]); w1.w = pk2(y[14], y[15]);
    *(u32x4*)op = w0; *(u32x4*)(op + 8) = w1;
}

__device__ __forceinline__ f32x2 cmul(f32x2 a, f32x2 w) { return (f32x2){a.x * w.x - a.y * w.y, a.x * w.y + a.y * w.x}; }
__device__ __forceinline__ void fft_unit(const float* GT, bf16_t* YC, LAS unsigned char* lds, int b, int g, int m, bool isctx, int pflags = 0) {
    const int tid = tidx();
    const int logL = isctx ? 8 : 13, Lf = 1 << logL, tok0 = isctx ? MLAT + b * CTXL : b * SEQ;
    LAS f32x2* X = (LAS f32x2*)lds; const LAS f32x2* tw = (const LAS f32x2*)(lds + 73728);
    const float* gr = GT + (size_t)(g * 128 + m) * MTOT + tok0; const float* gi = (m == 0) ? gr + (size_t)32 * MTOT : gr + (size_t)64 * MTOT;
    __syncthreads();
    for (int i = tid; i < Lf; i += 512) X[i] = (f32x2){gr[i], gi[i]};
    __syncthreads();
    int s = 0;
    for (; s + 1 < logL; s += 2) {
        const int qb = logL - 2 - s, quarter = 1 << qb;
        const LAS f32x2* tw1 = tw + (8192 - (8192 >> (s + 13 - logL)));
        const LAS f32x2* tw2 = tw + (8192 - (8192 >> (s + 14 - logL)));
        for (int t = tid; t < (Lf >> 2); t += 512) {
            const int j = t & (quarter - 1), i0 = ((t >> qb) << (qb + 2)) + j;
            const f32x2 a = X[i0], bq = X[i0 + quarter], c = X[i0 + 2 * quarter], d = X[i0 + 3 * quarter];
            const f32x2 w1 = tw1[j], w2 = tw2[j];
            const f32x2 t0 = {a.x + c.x, a.y + c.y}, t1 = {a.x - c.x, a.y - c.y}, t2 = {bq.x + d.x, bq.y + d.y};
            const f32x2 t3 = {bq.y - d.y, d.x - bq.x};
            const f32x2 w3 = cmul(w1, w2);
            X[i0] = (f32x2){t0.x + t2.x, t0.y + t2.y};
            X[i0 + quarter] = cmul((f32x2){t0.x - t2.x, t0.y - t2.y}, w2);
            X[i0 + 2 * quarter] = cmul((f32x2){t1.x + t3.x, t1.y + t3.y}, w1);
            X[i0 + 3 * quarter] = cmul((f32x2){t1.x - t3.x, t1.y - t3.y}, w3);
        }
        __syncthreads();
    }
    if (s < logL) {
        for (int t = tid; t < (Lf >> 1); t += 512) { const f32x2 a = X[2 * t], bb = X[2 * t + 1]; X[2 * t] = (f32x2){a.x + bb.x, a.y + bb.y}; X[2 * t + 1] = (f32x2){a.x - bb.x, a.y - bb.y}; }
        __syncthreads();
    }
    const float scale = 1.0f / sqrtf((float)Lf * 64.0f);
    if (pflags & 2) return;
    unsigned* yo = (unsigned*)(YC + (size_t)tok0 * DM + g * 64 + 2 * m);
    const int sh = 32 - logL;
    if (m != 0) {
        for (int k = tid; k < Lf; k += 512) { const int i1 = (int)(__brev((unsigned)k) >> sh), i2 = (int)(__brev((unsigned)((Lf - k) & (Lf - 1))) >> sh);
            yo[(size_t)k * (DM / 2)] = pk2(X[i1].x * scale, X[i2].x * scale); }
    } else {
        const float hs = 0.5f * scale;
        for (int k = tid; k < Lf; k += 512) { const int i1 = (int)(__brev((unsigned)k) >> sh), i2 = (int)(__brev((unsigned)((Lf - k) & (Lf - 1))) >> sh);
            const f32x2 z = X[i1], zp = X[i2]; yo[(size_t)k * (DM / 2)] = pk2((z.x + zp.x) * hs, (z.y + zp.y) * hs); }
    }
}

typedef short bf16x8 __attribute__((ext_vector_type(8)));
typedef float f32x16 __attribute__((ext_vector_type(16)));
typedef __bf16 bf16x2_t __attribute__((ext_vector_type(2)));
#define MFMA32(a, b, c) __builtin_amdgcn_mfma_f32_32x32x16_bf16((a), (b), (c), 0, 0, 0)
__device__ __forceinline__ unsigned cvtpk(float lo, float hi) { f32x2 v = {lo, hi}; bf16x2_t b = __builtin_convertvector(v, bf16x2_t); return __builtin_bit_cast(unsigned, b); }
template <int S> __device__ __forceinline__ bf16x8 pack8(const f32x16& x) {
    u32x4 p; p.x = cvtpk(x[8 * S], x[8 * S + 1]); p.y = cvtpk(x[8 * S + 2], x[8 * S + 3]); p.z = cvtpk(x[8 * S + 4], x[8 * S + 5]); p.w = cvtpk(x[8 * S + 6], x[8 * S + 7]);
    return __builtin_bit_cast(bf16x8, p);
}
__device__ __forceinline__ f32x16 zero16() { f32x16 z; float zz = 0.f; asm volatile("" : "+v"(zz));
#pragma unroll
    for (int i = 0; i < 16; ++i) z[i] = zz;
    return z; }
__device__ __forceinline__ void ldg_rows(const bf16_t* src, int ld, int tid, u32x4& a, u32x4& b) { const bf16_t* p = src + (size_t)(tid >> 2) * ld + (tid & 3) * 16; a = *(const u32x4*)p; b = *(const u32x4*)(p + 8); }
__device__ __forceinline__ void sts_rows(LAS unsigned char* dst, int tid, const u32x4& a, const u32x4& b) { LAS u32x4* o = (LAS u32x4*)(dst + (tid >> 2) * 144 + (tid & 3) * 32); o[0] = a; o[1] = b; }
__device__ __forceinline__ void ldg_cols(const bf16_t* src, int tid, u32x4& a, u32x4& b) { const bf16_t* p = src + (size_t)(tid >> 3) * MTOT + (tid & 7) * 16; a = *(const u32x4*)p; b = *(const u32x4*)(p + 8); }
__device__ __forceinline__ void sts_cols(LAS unsigned char* dst, int tid, const u32x4& a, const u32x4& b) { LAS u32x2* o = (LAS u32x2*)(dst + (tid >> 3) * 264 + (tid & 7) * 32);
    o[0] = (u32x2){a.x, a.y}; o[1] = (u32x2){a.z, a.w}; o[2] = (u32x2){b.x, b.y}; o[3] = (u32x2){b.z, b.w}; }
__device__ __forceinline__ bf16x8 vt_frag(const LAS unsigned char* Vt, int frow, int k0, int hi) {
    const LAS unsigned char* vp = Vt + frow * 264 + (k0 + 4 * hi) * 2; const u32x2 lo = *(const LAS u32x2*)vp, hh = *(const LAS u32x2*)(vp + 16);
    return __builtin_bit_cast(bf16x8, (u32x4){lo.x, lo.y, hh.x, hh.y});
}

__device__ __forceinline__ void attn_unit_mfma(const bf16_t* PN, const bf16_t* VT, bf16_t* YC, const float* sink, LAS unsigned char* lds, int b, int kvh, int qt, bool isctx) {
    const int tid = tidx(), lane = tid & 63, wid = __builtin_amdgcn_readfirstlane(tid >> 6), q32 = lane & 31, hi = lane >> 5;
    const int g = wid >> 1, qh = wid & 1, head = kvh * 4 + g;
    const int row0 = isctx ? MLAT + b * CTXL + 128 * qt : b * SEQ + 128 * qt;
    LAS unsigned char* Ks = lds; LAS unsigned char* Vt = lds + 18432;
    LAS unsigned char* Qf = lds + 36864 + wid * 8192 + lane * 16;
    __syncthreads();
#pragma unroll
    for (int qs = 0; qs < 2; ++qs)
#pragma unroll
        for (int ks = 0; ks < 4; ++ks) *(LAS bf16x8*)(Qf + (qs * 4 + ks) * 1024) = *(const bf16x8*)(PN + (size_t)(row0 + 64 * qh + 32 * qs + q32) * PN_LD + 768 + head * 64 + 16 * ks + 8 * hi);
    f32x16 o[2][2];
#pragma unroll
    for (int qs = 0; qs < 2; ++qs) { o[qs][0] = zero16(); o[qs][1] = zero16(); }
    const float sk = sink[head] * LOG2E;
    float mx[2] = {sk, sk}; float l[2] = {hi ? 0.f : 1.f, hi ? 0.f : 1.f};
    unsigned mask = isctx ? 0x18u : (0x1Au | (qt > 0 ? 1u : 0u) | (qt < 63 ? 4u : 0u));
    int ch = __builtin_ctz(mask);
    u32x4 ka, kb, va, vb;
    { const int krow0 = ch < 3 ? b * SEQ + 128 * (qt - 1 + ch) : MLAT + b * CTXL + 128 * (ch - 3);
      ldg_rows(PN + (size_t)krow0 * PN_LD + 1280 + kvh * 64, PN_LD, tid, ka, kb); ldg_cols(VT + (size_t)(256 + kvh * 64) * MTOT + krow0, tid, va, vb); }
    for (;;) {
        __syncthreads();
        sts_rows(Ks, tid, ka, kb); sts_cols(Vt, tid, va, vb);
        __syncthreads();
        mask &= mask - 1u;
        const int cur = ch;
        if (mask) { ch = __builtin_ctz(mask); const int krow0 = ch < 3 ? b * SEQ + 128 * (qt - 1 + ch) : MLAT + b * CTXL + 128 * (ch - 3);
            const int t2 = tidx();
            ldg_rows(PN + (size_t)krow0 * PN_LD + 1280 + kvh * 64, PN_LD, t2, ka, kb); ldg_cols(VT + (size_t)(256 + kvh * 64) * MTOT + krow0, t2, va, vb); }
        const float sgnbig = (cur == 0) ? 1e30f : -1e30f;
#pragma unroll
        for (int kt = 0; kt < 4; ++kt) {
            asm volatile("" ::: "memory");
            f32x16 s[2]; s[0] = zero16(); s[1] = zero16();
#pragma unroll
            for (int ks = 0; ks < 4; ++ks) { const bf16x8 a = *(const LAS bf16x8*)(Ks + (kt * 32 + q32) * 144 + ks * 32 + hi * 16);
                s[0] = MFMA32(a, *(const LAS bf16x8*)(Qf + (0 * 4 + ks) * 1024), s[0]); s[1] = MFMA32(a, *(const LAS bf16x8*)(Qf + (1 * 4 + ks) * 1024), s[1]); }
            bf16x8 pk[2][2];
#pragma unroll
            for (int qs = 0; qs < 2; ++qs) {
                if (cur == 0 || cur == 2) {
                    float thr = (float)(64 * qh + 32 * qs + q32 - 4 * hi); asm volatile("" : "+v"(thr));
#pragma unroll
                    for (int r = 0; r < 16; ++r) { const float jc = (float)(kt * 32 + (r & 3) + 8 * (r >> 2)); s[qs][r] += fminf(0.f, (jc - thr) * sgnbig); } }
                float mloc = fmaxf(fmaxf(s[qs][0], s[qs][1]), fmaxf(s[qs][2], s[qs][3]));
#pragma unroll
                for (int r = 4; r < 16; r += 4) mloc = fmaxf(mloc, fmaxf(fmaxf(s[qs][r], s[qs][r + 1]), fmaxf(s[qs][r + 2], s[qs][r + 3])));
                mloc = fmaxf(mloc, __shfl_xor(mloc, 32));
                const float mnew = fmaxf(mx[qs], mloc), alpha = fexp2(mx[qs] - mnew); mx[qs] = mnew;
                float ls = 0.f;
#pragma unroll
                for (int r = 0; r < 16; ++r) { const float p = fexp2(s[qs][r] - mnew); s[qs][r] = p; ls += p; }
                l[qs] = l[qs] * alpha + ls;
                if (__builtin_amdgcn_ballot_w64(alpha != 1.0f)) { o[qs][0] = o[qs][0] * alpha; o[qs][1] = o[qs][1] * alpha; }
                pk[qs][0] = pack8<0>(s[qs]); pk[qs][1] = pack8<1>(s[qs]);
            }
#pragma unroll
            for (int dt = 0; dt < 2; ++dt) {
                const bf16x8 va = vt_frag(Vt, dt * 32 + q32, kt * 32, hi), vb = vt_frag(Vt, dt * 32 + q32, kt * 32 + 16, hi);
                o[0][dt] = MFMA32(va, pk[0][0], o[0][dt]); o[1][dt] = MFMA32(va, pk[1][0], o[1][dt]);
                o[0][dt] = MFMA32(vb, pk[0][1], o[0][dt]); o[1][dt] = MFMA32(vb, pk[1][1], o[1][dt]); }
        }
        if (!mask) break;
    }
    const int t3 = tidx(), q32b = t3 & 31, hib = (t3 >> 5) & 1;
#pragma unroll
    for (int qs = 0; qs < 2; ++qs) {
        const float lt = l[qs] + __shfl_xor(l[qs], 32), inv = 1.0f / lt;
        bf16_t* op = YC + (size_t)(row0 + 64 * qh + 32 * qs + q32b) * DM + 512 + head * 64;
#pragma unroll
        for (int dt = 0; dt < 2; ++dt)
#pragma unroll
            for (int rg = 0; rg < 4; ++rg) { u32x2 w; w.x = cvtpk(o[qs][dt][4 * rg] * inv, o[qs][dt][4 * rg + 1] * inv); w.y = cvtpk(o[qs][dt][4 * rg + 2] * inv, o[qs][dt][4 * rg + 3] * inv);
                *(u32x2*)(op + dt * 32 + 8 * rg + 4 * hib) = w; }
    }
}

__device__ __forceinline__ void ret_out_unit_mfma(const bf16_t* PN, const bf16_t* VT, const float* KV, bf16_t* YC, const float* decay, const float* gnw, LAS unsigned char* lds, int b, int h, int c) {
    const int tid = tidx(), lane = tid & 63, wid = __builtin_amdgcn_readfirstlane(tid >> 6), q32 = lane & 31, hi = lane >> 5;
    const int pt = wid >> 1, dt = wid & 1;
    LAS unsigned char* Ks = lds; LAS unsigned char* Vt = lds + 18432; LAS unsigned char* S0t = lds + 35328; LAS unsigned char* S1t = lds + 44544; LAS float* Out = (LAS float*)(lds + 53760);
    const int row0 = chunk_row0(b, c);
    __syncthreads();
    { u32x4 ka, kb, va, vb; ldg_rows(PN + (size_t)row0 * PN_LD + 256 + h * 64, PN_LD, tid, ka, kb); ldg_cols(VT + (size_t)(h * 64) * MTOT + row0, tid, va, vb);
      const float* s0 = KV + ((size_t)((0 * 2 + b) * 4 + h) * NCHUNK + c) * 4096 + tid * 8; const float* s1 = KV + ((size_t)((1 * 2 + b) * 4 + h) * NCHUNK + c) * 4096 + tid * 8;
      const f32x4 a0 = *(const f32x4*)s0, a1 = *(const f32x4*)(s0 + 4), b0 = *(const f32x4*)s1, b1 = *(const f32x4*)(s1 + 4);
      sts_rows(Ks, tid, ka, kb); sts_cols(Vt, tid, va, vb);
      const int dv = tid >> 3, dk0 = (tid & 7) * 8;
      *(LAS u32x4*)(S0t + dv * 144 + dk0 * 2) = (u32x4){cvtpk(a0[0], a0[1]), cvtpk(a0[2], a0[3]), cvtpk(a1[0], a1[1]), cvtpk(a1[2], a1[3])};
      *(LAS u32x4*)(S1t + dv * 144 + dk0 * 2) = (u32x4){cvtpk(b0[0], b0[1]), cvtpk(b0[2], b0[3]), cvtpk(b1[0], b1[1]), cvtpk(b1[2], b1[3])}; }
    bf16x8 qf[4];
#pragma unroll
    for (int ks = 0; ks < 4; ++ks) qf[ks] = *(const bf16x8*)(PN + (size_t)(row0 + 32 * pt + q32) * PN_LD + h * 64 + 16 * ks + 8 * hi);
    const float lg0 = decay[h], lg1 = decay[4 + h];
    __syncthreads();
    const int p = 32 * pt + q32;
    f32x16 o = zero16();
#pragma unroll
    for (int kt = 0; kt < 4; ++kt) {
        f32x16 s = zero16();
#pragma unroll
        for (int ks = 0; ks < 4; ++ks) { const bf16x8 a = *(const LAS bf16x8*)(Ks + (kt * 32 + q32) * 144 + ks * 32 + hi * 16); s = MFMA32(a, qf[ks], s); }
#pragma unroll
        for (int r = 0; r < 16; ++r) { const int pp = kt * 32 + (r & 3) + 8 * (r >> 2) + 4 * hi; const float df = (float)(p - pp);
            const float ex = fexp2((df > 0.f ? lg0 : -lg1) * df); const float dec = (df == 0.f) ? 2.0f : ex; s[r] *= dec; }
        o = MFMA32(vt_frag(Vt, dt * 32 + q32, kt * 32, hi), pack8<0>(s), o);
        o = MFMA32(vt_frag(Vt, dt * 32 + q32, kt * 32 + 16, hi), pack8<1>(s), o);
    }
    {   f32x16 x0 = zero16(), x1 = zero16();
#pragma unroll
        for (int ks = 0; ks < 4; ++ks) { const bf16x8 a0 = *(const LAS bf16x8*)(S0t + (dt * 32 + q32) * 144 + ks * 32 + hi * 16), a1 = *(const LAS bf16x8*)(S1t + (dt * 32 + q32) * 144 + ks * 32 + hi * 16);
            x0 = MFMA32(a0, qf[ks], x0); x1 = MFMA32(a1, qf[ks], x1); }
        const float f0 = fexp2(lg0 * (float)(p + 1)), f1 = fexp2(lg1 * (float)(128 - p));
        o = o + x0 * f0 + x1 * f1; }
#pragma unroll
    for (int rg = 0; rg < 4; ++rg) *(LAS f32x4*)(Out + p * 68 + dt * 32 + 8 * rg + 4 * hi) = (f32x4){o[4 * rg], o[4 * rg + 1], o[4 * rg + 2], o[4 * rg + 3]};
    __syncthreads();
    const int p2 = tid >> 2, dvq = tid & 3;
    float out[16];
#pragma unroll
    for (int v4 = 0; v4 < 4; ++v4) { const f32x4 t = *(const LAS f32x4*)(Out + p2 * 68 + dvq * 16 + 4 * v4); out[4 * v4] = t[0]; out[4 * v4 + 1] = t[1]; out[4 * v4 + 2] = t[2]; out[4 * v4 + 3] = t[3]; }
    float sm = 0.f;
#pragma unroll
    for (int v = 0; v < 16; ++v) sm += out[v];
    sm += __shfl_xor(sm, 1); sm += __shfl_xor(sm, 2);
    const float mu = sm * (1.0f / 64.0f);
    float qv = 0.f;
#pragma unroll
    for (int v = 0; v < 16; ++v) { const float d = out[v] - mu; qv += d * d; }
    qv += __shfl_xor(qv, 1); qv += __shfl_xor(qv, 2);
    const float rstd = 1.0f / sqrtf(qv * (1.0f / 64.0f) + NORM_EPS);
    const bf16_t* gp = PN + (size_t)(row0 + p2) * PN_LD + 512 + h * 64 + dvq * 16;
    const u32x4 ga = *(const u32x4*)gp, gb = *(const u32x4*)(gp + 8);
    const float gt[16] = {bf_lo(ga.x), bf_hi(ga.x), bf_lo(ga.y), bf_hi(ga.y), bf_lo(ga.z), bf_hi(ga.z), bf_lo(ga.w), bf_hi(ga.w), bf_lo(gb.x), bf_hi(gb.x), bf_lo(gb.y), bf_hi(gb.y), bf_lo(gb.z), bf_hi(gb.z), bf_lo(gb.w), bf_hi(gb.w)};
    float y[16];
#pragma unroll
    for (int v = 0; v < 16; ++v) y[v] = silu_f(gt[v]) * ((out[v] - mu) * rstd * gnw[h * 64 + dvq * 16 + v]);
    bf16_t* op = YC + (size_t)(row0 + p2) * DM + 256 + h * 64 + dvq * 16;
    u32x4 w0, w1;
    w0.x = cvtpk(y[0], y[1]); w0.y = cvtpk(y[2], y[3]); w0.z = cvtpk(y[4], y[5]); w0.w = cvtpk(y[6], y[7]);
    w1.x = cvtpk(y[8], y[9]); w1.y = cvtpk(y[10], y[11]); w1.z = cvtpk(y[12], y[13]); w1.w = cvtpk(y[14], y[15]);
    *(u32x4*)op = w0; *(u32x4*)(op + 8) = w1;
}

__device__ __forceinline__ void ret_kv_unit_mfma(const bf16_t* PN, const bf16_t* VT, float* KV, const float* decay, LAS unsigned char* lds, int b, int h, int c) {
    const int tid = tidx(), lane = tid & 63, wid = __builtin_amdgcn_readfirstlane(tid >> 6), q32 = lane & 31, hi = lane >> 5;
    const int dir = wid >> 2, dt = (wid >> 1) & 1, nt = wid & 1;
    LAS unsigned char* Ks = lds; LAS unsigned char* Vt = lds + 18432; LAS f32x2* wt = (LAS f32x2*)(lds + 35328);
    const int row0 = chunk_row0(b, c);
    __syncthreads();
    { u32x4 ka, kb, va, vb; ldg_rows(PN + (size_t)row0 * PN_LD + 256 + h * 64, PN_LD, tid, ka, kb); ldg_cols(VT + (size_t)(h * 64) * MTOT + row0, tid, va, vb);
      sts_rows(Ks, tid, ka, kb); sts_cols(Vt, tid, va, vb);
      if (tid < 128) wt[tid] = (f32x2){fexp2(decay[h] * (float)(127 - tid)), fexp2(decay[4 + h] * (float)tid)}; }
    __syncthreads();
    f32x16 acc = zero16();
#pragma unroll
    for (int ks = 0; ks < 8; ++ks) {
        const LAS unsigned char* vp = Vt + (32 * dt + q32) * 264 + (16 * ks + 8 * hi) * 2;
        const u32x2 lo = *(const LAS u32x2*)vp, hh = *(const LAS u32x2*)(vp + 8);
        const bf16x8 a = __builtin_bit_cast(bf16x8, (u32x4){lo.x, lo.y, hh.x, hh.y});
        float kw[8];
#pragma unroll
        for (int e = 0; e < 8; ++e) { const int p = 16 * ks + 8 * hi + e; const unsigned kv = *(const LAS unsigned short*)(Ks + p * 144 + (32 * nt + q32) * 2);
            const f32x2 w = wt[p]; kw[e] = __builtin_bit_cast(float, kv << 16) * (dir ? w.y : w.x); }
        const bf16x8 bq = __builtin_bit_cast(bf16x8, (u32x4){cvtpk(kw[0], kw[1]), cvtpk(kw[2], kw[3]), cvtpk(kw[4], kw[5]), cvtpk(kw[6], kw[7])});
        acc = MFMA32(a, bq, acc);
    }
    float* o = KV + ((size_t)((dir * 2 + b) * 4 + h) * NCHUNK + c) * 4096 + 32 * nt + q32;
#pragma unroll
    for (int r = 0; r < 16; ++r) o[(32 * dt + (r & 3) + 8 * (r >> 2) + 4 * hi) * 64] = acc[r];
}

typedef __attribute__((address_space(4))) const Params* KParams;
__device__ __forceinline__ KParams kparams() { KParams p = (KParams)__builtin_amdgcn_kernarg_segment_ptr(); asm volatile("" : "+s"(p)); return p; }
struct UniEpi {
    static constexpr bool PERM = false, AFTER_DRAIN = false;
    int mode;
    int L;
    int midx;
    LAS unsigned char* xl;
    __device__ __forceinline__ void operator()(const f32x4 (&acc)[2][2][4][2], const Unit& u, int wr, int wc, int fr, int fq) const {
        KParams K = kparams(); unsigned char* ws = K->ws;
        if (mode == 3 || mode == 4) return;
        if (mode == 0) { EpiSwiglu E{(bf16_t*)(ws + OFF_ACT)}; E(acc, u, wr, wc, fr, fq); }
        else if (mode == 1) { const bool first = (midx & 256) != 0; const int mi = midx & 255; float* HC = (float*)(ws + OFF_HC);
            EpiResid E{first ? K->x : K->out, first ? K->ctx : HC, K->out, HC, (const float*)(ws + OFF_MOD) + (size_t)(L * 27 + mi) * DM, mi == 5 ? 1.0f : 0.5f}; E(acc, u, wr, wc, fr, fq); }
        else { EpiInProj E{(bf16_t*)(ws + OFF_PN), (float*)(ws + OFF_GT), (bf16_t*)(ws + OFF_VT), (const float*)(ws + OFF_ROPE), 66 + 10 * L, 72 + 10 * L}; E(acc, u, wr, wc, fr, fq); }
    }
    __device__ __forceinline__ void tail(f32x4 (&acc)[2][2][4][2], const Unit& u, int wr, int wc, int fr, int fq) const {
        if (mode != 4) return;
        KParams K = kparams(); unsigned char* ws = K->ws;
        { const bool first = (midx & 256) != 0; const int mi = midx & 255; float* HC = (float*)(ws + OFF_HC);
            const int kk = mi == 2 ? 0 : (mi == 5 ? 1 : 2), nL = (kk == 2 && L == 0) ? 1 : L, widx = (kk == 0) ? 1 : (kk == 1 ? 2 : 0), ni = (kk == 0) ? 3 : (kk == 1 ? 6 : 0);
            const float* modN = (const float*)(ws + OFF_MOD) + (size_t)nL * 27 * DM;
            epi_resid_norm(acc, u, wr, wc, fr, fq, first ? K->x : K->out, first ? K->ctx : HC, K->out, HC, (const float*)(ws + OFF_MOD) + (size_t)(L * 27 + mi) * DM, mi == 5 ? 1.0f : 0.5f,
                           K->norm_w + (size_t)(nL * 3 + widx) * DM, modN + (size_t)ni * DM, modN + (size_t)(ni + 1) * DM, (bf16_t*)(ws + OFF_R),
                           (float*)(ws + OFF_XBUF) + (size_t)(L * 3 + kk) * MTOT * 4, (unsigned*)(ws + OFF_BAR + 65536) + (size_t)((L * 3 + kk) * 66) * 64, xl, (L == 1 && kk == 2) ? K->final_norm_w : nullptr); }
    }
};
__device__ __forceinline__ void gate_signal(unsigned* cnt) {
    asm volatile("s_waitcnt vmcnt(0)" ::: "memory");
    __builtin_amdgcn_fence(__ATOMIC_RELEASE, "agent");
    asm volatile("s_waitcnt vmcnt(0)" ::: "memory");
    if ((tidx() & 63) == 0) __hip_atomic_fetch_add(cnt, 1u, __ATOMIC_RELAXED, __HIP_MEMORY_SCOPE_AGENT);
}
__device__ __forceinline__ void gate_wait(unsigned* cnt, unsigned need) {
    if (tidx() < 64) { unsigned sp = 0;
        while ((unsigned)__builtin_amdgcn_readfirstlane(__hip_atomic_load(cnt, __ATOMIC_RELAXED, __HIP_MEMORY_SCOPE_AGENT)) < need) { __builtin_amdgcn_s_sleep(2); if (++sp > (1u << 22)) break; }
        __builtin_amdgcn_fence(__ATOMIC_ACQUIRE, "agent"); asm volatile("s_waitcnt vmcnt(0)" ::: "memory"); }
    __syncthreads();
}
__device__ __forceinline__ void wg_signal(unsigned* cnt) {
    asm volatile("s_waitcnt vmcnt(0)" ::: "memory"); __syncthreads();
    if (tidx() == 0) { __builtin_amdgcn_fence(__ATOMIC_RELEASE, "agent"); asm volatile("s_waitcnt vmcnt(0)" ::: "memory"); __hip_atomic_fetch_add(cnt, 1u, __ATOMIC_RELAXED, __HIP_MEMORY_SCOPE_AGENT); }
}
constexpr int NDED = 8, NWORK = 256 - NDED;
struct UniSched {
    int mode; pg8::StaticOrder so; int L; unsigned* cnt;
    __device__ __forceinline__ bool next(int i, Unit& u) const {
        if (mode == 0) return so.next(i, u);
        if (mode == 1) { InSched is{so.G, so.c, 66 + 10 * L, 72 + 10 * L}; return is.next(i, u); }
        if (mode == 2) { if (so.c >= NWORK) return false; const int lin = i * NWORK + so.c;
            if (lin < 44) { u.pm = 64 + lin / 22; u.pn = lin % 22; return true; }
            if (lin - 44 >= 64 * 22) return false;
            pg8::StaticOrder t = so; t.G = 0; t.c = lin - 44; return t.next(0, u); }
        if (i > 0 || so.c < NWORK) return false;
        u.pm = 64 + ((so.c - NWORK) >> 2); u.pn = (so.c - NWORK) & 3; return true;
    }
    __device__ __forceinline__ void a_ready(const Unit&) const {}
    __device__ __forceinline__ void done(const Unit& u) const { if (mode == 2 && cnt != nullptr && u.pm >= 64) gate_signal(cnt); }
};


#ifdef ATT_VALU
#define ATTN_FN attn_unit
#else
#define ATTN_FN attn_unit_mfma
#endif
#ifdef KV_VALU
#define KV_FN ret_kv_unit
#else
#define KV_FN ret_kv_unit_mfma
#endif
#ifdef RO_VALU
#define RO_FN ret_out_unit
#else
#define RO_FN ret_out_unit_mfma
#endif

constexpr int LDS_ST_OFF = LDS_BYTES - 16;
__device__ __forceinline__ void grid_barrier(LAS unsigned char* lds) {
#ifdef USE_CG_SYNC
    cg::this_grid().sync();
#else
    XcdBarrier b; b.bar = (unsigned*)(kparams()->ws + OFF_BAR); b.x = xb_xcc_id(); b.st = (volatile LAS unsigned*)(lds + LDS_ST_OFF);
    xcd_barrier(b);
#endif
}
#ifndef FUSE_NORM
#define FUSE_NORM 1
#endif
#ifndef MERGE_MIX
#define MERGE_MIX 0
#endif
#ifndef FUSE2
#define FUSE2 1
#endif
#ifndef FUSE_FINAL
#define FUSE_FINAL 0
#endif
__global__ void __launch_bounds__(512) fwd_megakernel(Params Pin) {
    extern __shared__ __attribute__((aligned(16))) unsigned char lds_raw[];
    LAS unsigned char* lds = (LAS unsigned char*)lds_raw;
#ifndef USE_CG_SYNC
    if (tidx() < 4) ((LAS unsigned*)(lds + LDS_ST_OFF))[tidx()] = 0u;
    __syncthreads();
    (void)xcd_barrier_post((unsigned*)(kparams()->ws + OFF_BAR), (volatile LAS unsigned*)(lds + LDS_ST_OFF));
    if (kparams()->ws == nullptr) cg::this_grid().sync();
#endif
#ifdef PROBE_REP
#define NREP(t) ((((PROBE_REP) >> (t)) & 1) ? 2 : 1)
#define XSYNC() do { if (((PROBE_REP) >> 9) & 1) grid_barrier(lds); } while (0)
#else
#define NREP(t) 1
#define XSYNC() do {} while (0)
#endif
    for (int rep = 0; rep < NREP(0); ++rep) {
#ifndef NO_P0
        p0_prologue(*kparams(), lds);
#endif
    }
    grid_barrier(lds); XSYNC();
    for (int L = 0; L < 2; ++L)
    for (int r = 0; r < 12; ++r) {
        const int ptype = (r == 0 || r == 3 || r == 9) ? 1 : ((r == 1 || r == 10) ? 2 : ((r == 2 || r == 11) ? 3 : r));
        const int nrep = NREP(ptype);
      for (int rep = 0; rep < nrep; ++rep) {
        KParams K = kparams();
        unsigned char* ws = K->ws;
        const int G = gdim(), bx = bidx();
        {

            const float* modL = (const float*)(ws + OFF_MOD) + (size_t)L * 3 * 9 * DM;
            float* HC = (float*)(ws + OFF_HC);
            bf16_t* Rb = (bf16_t*)(ws + OFF_R);
            if ((r == 0 || r == 3 || r == 9) && !((FUSE_NORM || FUSE2) && G == 256 && !(L == 0 && r == 0))) {
                const bool first = (L == 0 && r == 0);
                const int widx = r == 0 ? 0 : (r == 3 ? 1 : 2), mi = r;
                const int nrows = (r == 9 && L == 1) ? MLAT : MTOT;
                norm_phase(first ? K->x : K->out, first ? K->ctx : HC, K->norm_w + (size_t)(L * 3 + widx) * DM, modL + (size_t)(mi == 9 ? 6 : mi) * DM, modL + (size_t)((mi == 9 ? 6 : mi) + 1) * DM, Rb, nrows);
            }
            int gk = 0;
            const bool split_ctx = (G == 256);
            if (r == 1 || r == 10) gk = 1; else if (r == 2 || r == 11) gk = 2; else if (r == 4) gk = 3; else if (r == 8) gk = 4;
            if (r >= 5 && r <= 7) {
                unsigned* ctl = (unsigned*)(ws + OFF_BAR) + 4096;

                const bf16_t* PN = (const bf16_t*)(ws + OFF_PN); const bf16_t* VT = (const bf16_t*)(ws + OFF_VT); bf16_t* YC = (bf16_t*)(ws + OFF_YCAT);
                float* KV = (float*)(ws + OFF_KV); const float* GT = (const float*)(ws + OFF_GT);
                const float* decay = (const float*)(ws + OFF_LG) + L * 8;
                if (MERGE_MIX && r == 5 && split_ctx) {
                    unsigned* kvc = ctl + (6 + L * 2) * 64; unsigned* scc = ctl + (7 + L * 2) * 64;
                    { const int tid = tidx(); const f32x2* twg = (const f32x2*)(ws + OFF_TW); LAS f32x2* tws = (LAS f32x2*)(lds + 73728); for (int i = tid; i < 8191; i += 512) tws[i] = twg[i]; }
                    for (int u = bx; u < 8 * NCHUNK; u += G) { const int c = u % NCHUNK, bh = u / NCHUNK;
                        KV_FN(PN, VT, KV, decay, lds, bh >> 2, bh & 3, c);
                        if (rep == 0) wg_signal(kvc); }
                    { const int bg = bx & 7, mm = bx >> 3;
                      fft_unit(GT, YC, lds, bg >> 2, bg & 3, mm, false, 0);
                      if (L == 0) fft_unit(GT, YC, lds, bg >> 2, bg & 3, mm, true, 0); }
                    ATTN_FN(PN, VT, YC, K->attn_sink + L * 8, lds, bx >> 7, (bx >> 6) & 1, bx & 63, false);
                    if (L == 0 && bx < 8) ATTN_FN(PN, VT, YC, K->attn_sink + L * 8, lds, bx >> 2, (bx >> 1) & 1, bx & 1, true);
                    if (rep == 0) {
                        gate_wait(kvc, 8 * NCHUNK);
                        if (bx < 128) { ret_scan_unit(KV, decay, bx); wg_signal(scc); }
                    }
                    gate_wait(scc, 128);
                    if (L == 0) {
                        unsigned* cnt = ctl + (L * 3 + 2) * 64;
                        if (bx < NWORK) {
                            for (int u = bx; u < 8 * NCHUNK; u += NWORK) {
                                const bool isc = u < 16; const int v = u - 16; const int bh = isc ? (u >> 1) : (v >> 6), c = isc ? 64 + (u & 1) : (v & 63);
                                RO_FN(PN, VT, KV, YC, decay, K->ret_gn_w + L * 256, lds, bh >> 2, bh & 3, c);
                                if (isc) gate_signal(cnt);
                            }
                        } else gk = 5;
                    } else {
                        for (int u = bx; u < 8 * 64; u += G) RO_FN(PN, VT, KV, YC, decay, K->ret_gn_w + L * 256, lds, (u >> 6) >> 2, (u >> 6) & 3, u & 63);
                    }
                } else if (MERGE_MIX && split_ctx) {
                } else if (r == 5) {
                    { const int tid = tidx(); const f32x2* twg = (const f32x2*)(ws + OFF_TW); LAS f32x2* tws = (LAS f32x2*)(lds + 73728); for (int i = tid; i < 8191; i += 512) tws[i] = twg[i]; }
                    for (int u = bx; u < 8 * NCHUNK; u += G) { const int c = u % NCHUNK, bh = u / NCHUNK;
#ifndef NO_KV
#ifdef PROBE_REP
                        if (rep > 0 && ((PROBE_REP) & 0x800)) continue;
#endif
                        KV_FN(PN, VT, KV, decay, lds, bh >> 2, bh & 3, c);
#endif
                    }
#ifndef NO_FFT
                    if (G == 256) {
#ifdef PROBE_REP
                      if (!(rep > 0 && ((PROBE_REP) & 0x400)))
#endif
                      {
                        const int bg = bx & 7, mm = bx >> 3;
#ifdef PROBE_REP
                        const int pf = rep > 0 ? (((PROBE_REP) >> 12) & 7) : 0;
#else
                        const int pf = 0;
#endif
                        fft_unit(GT, YC, lds, bg >> 2, bg & 3, mm, false, pf);
                        if (L == 0) fft_unit(GT, YC, lds, bg >> 2, bg & 3, mm, true, pf);
                      }
                    } else {
                        for (int u = bx; u < 256 * (L == 0 ? 2 : 1); u += G) { const int v = u & 255; fft_unit(GT, YC, lds, (v & 7) >> 2, v & 3, v >> 3, u >= 256, 0); }
                    }
#endif
                } else if (r == 6) {
                    const int n_sc = 128, n_al = 256, n_ac = (L == 0 && !split_ctx) ? 8 : 0;
                    for (int u = bx; u < n_sc + n_al + n_ac; u += G) {
                        if (u < n_sc) {
#ifndef NO_SCAN
                            if (rep == 0) ret_scan_unit(KV, decay, u);
#endif
                        } else {
                            const int v = u - n_sc; const bool isc = v >= n_al; const int w = v - n_al;
#ifndef NO_ATT
                            ATTN_FN(PN, VT, YC, K->attn_sink + L * 8, lds, isc ? (w >> 2) : (v >> 7), isc ? ((w >> 1) & 1) : ((v >> 6) & 1), isc ? (w & 1) : (v & 63), isc);
#endif
                        }
                    }
                } else {
                    if (L == 0 && split_ctx) {
                        unsigned* cnt = ctl + (L * 3 + 2) * 64;
                        if (bx < NWORK) {
                            for (int u = bx; u < 8 * NCHUNK; u += NWORK) {
                                const bool isc = u < 16; const int v = u - 16; const int bh = isc ? (u >> 1) : (v >> 6), c = isc ? 64 + (u & 1) : (v & 63);
#ifndef NO_RO
                                RO_FN(PN, VT, KV, YC, decay, K->ret_gn_w + L * 256, lds, bh >> 2, bh & 3, c);
                                if (isc) gate_signal(cnt);
#endif
                            }
                        } else {
                            const int w = bx - NWORK;
                            ATTN_FN(PN, VT, YC, K->attn_sink + L * 8, lds, w >> 2, (w >> 1) & 1, w & 1, true);
                            wg_signal(ctl + 12 * 64);
                            gate_wait(ctl + 12 * 64, (unsigned)NDED * (unsigned)(rep + 1));
                            gk = 5;
                        }
                    } else {
                        const int cpb = (L == 0) ? NCHUNK : 64, n_ro = 8 * cpb;
                        for (int u = bx; u < n_ro; u += G) { const int c = u % cpb, bh = u / cpb;
#ifndef NO_RO
                            RO_FN(PN, VT, KV, YC, decay, K->ret_gn_w + L * 256, lds, bh >> 2, bh & 3, c);
#endif
                        }
                    }
                }
            }
            if (gk != 0) {
                unsigned* ctl = (unsigned*)(ws + OFF_BAR) + 4096;
                const int j = (r == 10 || r == 11) ? 1 : 0; const bool with_ctx = !(L == 1 && j == 1);
                const int npass = (gk == 1 && with_ctx && split_ctx && rep == 0) ? 2 : 1;
                for (int pass = 0; pass < npass; ++pass) {
                    pg8::Gemm g; UniSched S; UniEpi E; unsigned* gate = nullptr; unsigned gate_need = 0;
                    E.mode = 0; E.L = L; E.midx = 0; S.mode = 0; S.L = L; S.cnt = nullptr;
                    int M = MTOT, N = DM; g.K = DM;
                    if (gk == 1 && pass == 0) {
                        N = 2 * DFF; g.A = Rb; g.Bt = (const bf16_t*)(ws + OFF_WFFIN + (size_t)(L * 2 + j) * SZ_WFFIN);
                        if (with_ctx && split_ctx) { M = MLAT; S.mode = 2; if (rep == 0) S.cnt = ctl + (L * 3 + j) * 64; } else M = with_ctx ? MTOT : MLAT;
                    } else if (gk == 2 || gk == 1) {
                        g.A = (const bf16_t*)(ws + OFF_ACT); g.Bt = (const bf16_t*)(ws + OFF_WFFOUT + (size_t)(L * 2 + j) * SZ_WFFOUT); g.K = DFF;
                        E.mode = 1; E.midx = (j == 0 ? 2 : 8) | ((L == 0 && j == 0) ? 256 : 0);
                        if (gk == 1) { S.mode = 3; gate = ctl + (L * 3 + j) * 64; gate_need = 44 * 8; } else M = (with_ctx && !split_ctx) ? MTOT : MLAT;
                    } else if (gk == 3) {
                        g.A = Rb; g.Bt = Rb; S.mode = 1; E.mode = 2;
                    } else {
                        g.A = (const bf16_t*)(ws + OFF_YCAT); g.Bt = (const bf16_t*)(ws + OFF_WO + (size_t)L * SZ_WO); E.mode = 1; E.midx = 5;
                        if (gk == 5) { S.mode = 3; gate = ctl + (L * 3 + 2) * 64; gate_need = 16 * 8; } else M = (L == 0 && !split_ctx) ? MTOT : MLAT;
                    }
                    E.xl = lds + 131072;
                    if (FUSE2 && split_ctx && E.mode == 1) E.mode = 4;
                    if (rep > 0 && (E.mode == 1 || E.mode == 4)) E.mode = 3;
                    g.M = M; g.N = N; S.so.init(M, N, G, bx);
                    if (gate != nullptr && bx >= NWORK) gate_wait(gate, gate_need);
#ifndef NO_GEMM
                    pg8::gemm_phase<UniEpi, UniSched, true, true>(lds, g, S, E);
#endif
                    if (FUSE_NORM && rep == 0 && (gk == 2 || gk == 4 || gk == 5 || (gk == 1 && pass == 1)) && gdim() == 256) {
                        const int jj = (r == 10 || r == 11) ? 1 : 0;
                        if (L == 1 && gk == 2 && jj == 1) { if (FUSE_FINAL) {
                            const int bx2 = bidx(); pg8::StaticOrder so2; so2.init(MLAT, DM, 256, bx2); Unit u0; so2.next(0, u0);
                            KParams K2 = kparams(); unsigned* pc = (unsigned*)(K2->ws + OFF_BAR + 65536) + (size_t)((L * 3 + 2) * 66 + u0.pm) * 64;
                            if (tidx() == 0) { __builtin_amdgcn_fence(__ATOMIC_RELEASE, "agent"); asm volatile("s_waitcnt vmcnt(0)" ::: "memory"); __hip_atomic_fetch_add(pc, 1u, __ATOMIC_RELAXED, __HIP_MEMORY_SCOPE_AGENT); }
                            gate_wait(pc, 4u);
                            final_norm_rows(K2->out, K2->final_norm_w, 256 * u0.pm + 64 * u0.pn, 64); }
                        } else {
                            const int bx2 = bidx(); int pm, pn;
                            if (gk == 2 || gk == 4) { pg8::StaticOrder so2; so2.init(MLAT, DM, 256, bx2); Unit u0; so2.next(0, u0); pm = u0.pm; pn = u0.pn; }
                            else { pm = bx2 >= NWORK ? 64 + ((bx2 - NWORK) >> 2) : -1; pn = (bx2 - NWORK) & 3; }
                            if (pm >= 0) {
                                KParams K2 = kparams(); unsigned char* ws2 = K2->ws;
                                const int kk = (gk == 4 || gk == 5) ? 1 : (jj == 0 ? 0 : 2);
                                unsigned* pc = (unsigned*)(ws2 + OFF_BAR + 65536) + (size_t)((L * 3 + kk) * 66 + pm) * 64;
                                if (tidx() == 0) { __builtin_amdgcn_fence(__ATOMIC_RELEASE, "agent"); asm volatile("s_waitcnt vmcnt(0)" ::: "memory"); __hip_atomic_fetch_add(pc, 1u, __ATOMIC_RELAXED, __HIP_MEMORY_SCOPE_AGENT); }
                                gate_wait(pc, 4u);
                                const int nL = (kk == 2) ? L + 1 : L, widx = (kk == 0) ? 1 : (kk == 1 ? 2 : 0), mi = (kk == 0) ? 3 : (kk == 1 ? 6 : 0);
                                const float* modN = (const float*)(ws2 + OFF_MOD) + (size_t)nL * 3 * 9 * DM;
                                norm_rows(K2->out, (const float*)(ws2 + OFF_HC), K2->norm_w + (size_t)(nL * 3 + widx) * DM, modN + (size_t)mi * DM, modN + (size_t)(mi + 1) * DM, (bf16_t*)(ws2 + OFF_R), 256 * pm + 64 * pn, 64);
                            }
                        }
                    }
                }
            }
        }
      }
        if ((FUSE_NORM || FUSE2) && gdim() == 256 && (r == 3 || r == 9 || (r == 0 && L == 1) || (MERGE_MIX && (r == 6 || r == 7)) || ((FUSE_FINAL || FUSE2) && r == 11 && L == 1))) continue;
        grid_barrier(lds); XSYNC();
    }
    if (!(((FUSE_NORM && FUSE_FINAL) || FUSE2) && gdim() == 256)) { KParams K = kparams(); final_norm_phase(K->out, K->final_norm_w); }
}

extern "C" void kernel_launch(void* const* d_in, const int* in_sizes, int n_in, void* d_out, int out_size, void* d_ws, size_t ws_size, hipStream_t stream) {
    static int grid_blocks = 0;
    if (grid_blocks == 0) {
        if (n_in != 15 || ws_size < WS_NEED) { fprintf(stderr, "kernel_launch: unexpected n_in %d or ws_size %zu (need %zu)\n", n_in, ws_size, (size_t)WS_NEED); grid_blocks = -1; return; }
        int dev = 0, cus = 0, per_cu = 0;
        (void)hipGetDevice(&dev);
        (void)hipDeviceGetAttribute(&cus, hipDeviceAttributeMultiprocessorCount, dev);
        (void)hipFuncSetAttribute((const void*)fwd_megakernel, hipFuncAttributeMaxDynamicSharedMemorySize, LDS_BYTES);
        (void)hipOccupancyMaxActiveBlocksPerMultiprocessor(&per_cu, (const void*)fwd_megakernel, 512, LDS_BYTES);
        if (per_cu < 1) fprintf(stderr, "kernel_launch: occupancy query says %d blocks/CU\n", per_cu);
        grid_blocks = cus;
        (void)hipGetLastError();
    }
    if (grid_blocks < 0) return;
    Params p{};
    p.x = (const float*)d_in[0]; p.c = (const float*)d_in[1]; p.ctx = (const float*)d_in[2]; p.c_ctx = (const float*)d_in[3]; p.norm_w = (const float*)d_in[4];
    p.w_ada = (const float*)d_in[5]; p.b_ada = (const float*)d_in[6]; p.ffn_w_in = (const float*)d_in[7]; p.ffn_w_out = (const float*)d_in[8]; p.w_in = (const float*)d_in[9];
    p.w_o = (const float*)d_in[10]; p.ret_decay = (const float*)d_in[11]; p.ret_gn_w = (const float*)d_in[12]; p.attn_sink = (const float*)d_in[13]; p.final_norm_w = (const float*)d_in[14];
    p.out = (float*)d_out; p.ws = (unsigned char*)d_ws;
#ifndef USE_CG_SYNC
    (void)hipMemsetAsync((char*)d_ws + OFF_BAR, 0, 262144, stream);
#endif
    void* args[] = {&p};
    hipError_t e = hipLaunchCooperativeKernel((const void*)fwd_megakernel, dim3(grid_blocks), dim3(512), args, LDS_BYTES, stream);
    if (e != hipSuccess) fprintf(stderr, "cooperative launch failed: %s (grid %d)\n", hipGetErrorString(e), grid_blocks);
}
```

```cpp
#define FUSE_NORM 0
#include <hip/hip_runtime.h>
#include <hip/hip_cooperative_groups.h>
#include <cstdio>
#include <cstdint>

__device__ __forceinline__ int tidx() { int t = threadIdx.x; asm volatile("" : "+v"(t)); return t; }
__device__ __forceinline__ int bidx() { int t = blockIdx.x; asm volatile("" : "+s"(t)); return t; }
__device__ __forceinline__ int gdim() { int t = gridDim.x; asm volatile("" : "+s"(t)); return t; }
#define LAS __attribute__((address_space(3)))
#define XB_TMO      128
#define XB_XCNT(j)  (256  + 64 * (j))
#define XB_XSUB(j)  (1280 + 64 * (j))
#define XB_XGEN(j)  (2304 + 64 * (j))
#define XB_TOP      3328
#define XB_TOPGEN   3392
#define XCD_BAR_WORDS 3456
#define XB_SPIN_CAP (1u << 18)

__device__ __forceinline__ unsigned xb_ld(unsigned* p)              { return __hip_atomic_load(p, __ATOMIC_RELAXED, __HIP_MEMORY_SCOPE_AGENT); }
__device__ __forceinline__ unsigned xb_add(unsigned* p, unsigned v) { return __hip_atomic_fetch_add(p, v, __ATOMIC_RELAXED, __HIP_MEMORY_SCOPE_AGENT); }
__device__ __forceinline__ unsigned xb_xcc_id() { return (unsigned)__builtin_amdgcn_s_getreg((3 << 11) | 20) & 0xFu; }
#define XB_SPIN(cond, bar) do { unsigned _sp = 0; while (cond) { __builtin_amdgcn_s_sleep(1); \
    if ((++_sp & 255u) == 0u) { if (xb_ld(&(bar)[XB_TMO])) break; if (_sp > XB_SPIN_CAP) { atomicAdd(&(bar)[XB_TMO], 1u); break; } } } } while (0)

struct XcdBarrier {
    unsigned* bar; unsigned x;
    volatile LAS unsigned* st;
};

__device__ __forceinline__ XcdBarrier xcd_barrier_post(unsigned* bar, volatile LAS unsigned* st) {
    XcdBarrier b; b.bar = bar; b.x = xb_xcc_id(); b.st = st;
    if (threadIdx.x == 0) (void)xb_add(&bar[XB_XCNT(b.x)], 1u);
    return b;
}
__device__ __forceinline__ void xcd_barrier_complete(unsigned* bar, unsigned x, unsigned& nloc, unsigned& nx) {
    const unsigned G = gridDim.x * gridDim.y * gridDim.z;
    unsigned sum, cnt, mine, sp = 0u;
    for (;;) {
        sum = 0u; cnt = 0u; mine = 0u;
#pragma unroll
        for (unsigned j = 0; j < 16; ++j) { const unsigned c = xb_ld(&bar[XB_XCNT(j)]); sum += c; cnt += (c > 0u) ? 1u : 0u; mine = (j == x) ? c : mine; }
        if (sum == G) break;
        __builtin_amdgcn_s_sleep(1);
        if ((++sp & 255u) == 0u) { if (xb_ld(&bar[XB_TMO])) break; if (sp > XB_SPIN_CAP) { atomicAdd(&bar[XB_TMO], 1u); break; } }
    }
    nloc = mine > 0u ? mine : 1u; nx = cnt > 0u ? cnt : 1u;
}

__device__ __forceinline__ void xcd_barrier(const XcdBarrier& b) {
    asm volatile("s_waitcnt vmcnt(0)" ::: "memory");
    __syncthreads();
    if (threadIdx.x == 0) {
        unsigned* bar = b.bar;
        __builtin_amdgcn_s_waitcnt(0);
        unsigned nloc = b.st[0], nx = b.st[1];
        if (nloc == 0u) { xcd_barrier_complete(bar, b.x, nloc, nx); b.st[0] = nloc; b.st[1] = nx; }
        const unsigned old = xb_add(&bar[XB_XSUB(b.x)], 1u);
        const unsigned gen = old / nloc;
        if (old + 1u == (gen + 1u) * nloc) {
            __builtin_amdgcn_fence(__ATOMIC_RELEASE, "agent");
            asm volatile("s_waitcnt vmcnt(0)" ::: "memory");
            const unsigned og = xb_add(&bar[XB_TOP], 1u);
            const unsigned tg = og / nx;
            if (og + 1u == (tg + 1u) * nx) xb_add(&bar[XB_TOPGEN], 1u);
            else XB_SPIN(xb_ld(&bar[XB_TOPGEN]) == tg, bar);
            __builtin_amdgcn_fence(__ATOMIC_ACQUIRE, "agent");
            xb_add(&bar[XB_XGEN(b.x)], 1u);
            asm volatile("s_waitcnt vmcnt(0)" ::: "memory");
        } else {
            XB_SPIN(xb_ld(&bar[XB_XGEN(b.x)]) == gen, bar);
            __builtin_amdgcn_fence(__ATOMIC_ACQUIRE, "agent");
            asm volatile("s_waitcnt vmcnt(0)" ::: "memory");
        }
    }
    __syncthreads();
}
namespace pg8 {
#define PG8_LAS __attribute__((address_space(3)))
typedef unsigned short bf16_t;
typedef short bf16x8 __attribute__((ext_vector_type(8)));
typedef float f32x4 __attribute__((ext_vector_type(4)));
typedef unsigned u32x4 __attribute__((ext_vector_type(4)));
constexpr int BM = 256, BK = 64, HALF = 128, HTB = HALF * BK * 2  , STAGE_BYTES = 8 * HTB, NXCD = 8, WGM = 8;

__host__ __device__ __forceinline__ int lds_byte(int r, int c) { const int st = (r >> 4) * 2 + (c >> 5), rr = r & 15, cc = c & 31, ob = rr * 64 + cc * 2; return st * 1024 + (ob ^ (((ob >> 9) & 1) << 5)); }
__host__ __device__ __forceinline__ void stage_rc(int b, int& R, int& C) { const int st = b / 1024, sb = b % 1024, swz = sb ^ (((sb >> 9) & 1) << 5); R = (st >> 1) * 16 + swz / 64; C = (st & 1) * 32 + (swz % 64) / 2; }
__host__ __device__ __forceinline__ int perm32(int rho) { const int n = rho >> 4, i = rho & 15; return 8 * (i >> 2) + 4 * n + (i & 3); }

struct Unit { int pm, pn; };
struct Gemm { const bf16_t* A; const bf16_t* Bt; int M, N, K; };

struct StaticOrder {
    int nM, nN, nwg, G, c;
    __host__ __device__ __forceinline__ void init(int M, int N, int G_, int c_) { nM = M / BM; nN = N / BM; nwg = nM * nN; G = G_; c = c_; }
    __host__ __device__ __forceinline__ bool next(int i, Unit& u) const {
        const long L = (long)i * G + c; if (L >= nwg) return false;
        int wgid = (int)L; { const int q = nwg / NXCD, r = nwg % NXCD, xcd = wgid % NXCD, off = wgid / NXCD; wgid = (xcd < r ? xcd * (q + 1) : r * (q + 1) + (xcd - r) * q) + off; }
        const int nig = WGM * nN, gid = wgid / nig, fm = gid * WGM, gsz = (nM - fm) < WGM ? (nM - fm) : WGM;
        u.pm = fm + ((wgid % nig) % gsz); u.pn = (wgid % nig) / gsz; return true;
    }
    __device__ __forceinline__ void a_ready(const Unit&) const {}
    __device__ __forceinline__ void done(const Unit&) const {}
};

__device__ __forceinline__ unsigned cvt_pk_bf16(float lo, float hi) { unsigned r; asm volatile("v_cvt_pk_bf16_f32 %0, %1, %2" : "=v"(r) : "v"(lo), "v"(hi)); return r; }
template <class Epi, class Sched, bool ALIGN_EPI = false, bool SP2 = false>
__device__ __forceinline__ void gemm_phase(PG8_LAS unsigned char* lds, const Gemm g, const Sched& S, const Epi& E) {
    const int tid = tidx(), wid = __builtin_amdgcn_readfirstlane(tid >> 6), lane = tid & 63, wr = wid >> 2, wc = wid & 3, fr = lane & 15, fq = lane >> 4;
    const int K = g.K, nt = K / BK;
    unsigned voffA[2], voffB[2];
#pragma unroll
    for (int i = 0; i < 2; ++i) { int R, C; stage_rc(tid * 16 + i * 8192, R, C); const int Rb = Epi::PERM ? ((R & ~31) + perm32(R & 31)) : R;
        voffA[i] = (unsigned)(R * K + C) * 2u; voffB[i] = (unsigned)(Rb * K + C) * 2u; }
    const size_t kstep = (size_t)(BK * 2);
    const size_t hstep = (size_t)HALF * K * 2;
    const size_t tstep = 2 * hstep;
    const unsigned ldsw = (unsigned)wid * 1024u;
    const int aoff = lds_byte(wr * 64 + fr, fq * 8), boff = lds_byte(wc * 32 + fr, fq * 8);
#define PG8_SA(b, h) (((b) * 2 + (h)) * HTB)
#define PG8_SB(b, h) ((4 + (b) * 2 + (h)) * HTB)
#define PG8_STAGE(bufoff, gbase, voff) do { _Pragma("unroll") for (int _i = 0; _i < 2; ++_i) \
        __builtin_amdgcn_global_load_lds((const unsigned*)((const char*)(gbase) + (voff)[_i]), (PG8_LAS unsigned*)(lds + (bufoff) + ldsw + _i * 8192), 16, 0, 0); } while (0)
#define PG8_LDA(dst, b, h) do { _Pragma("unroll") for (int m = 0; m < 4; ++m) _Pragma("unroll") for (int k = 0; k < 2; ++k) dst[m][k] = *(const PG8_LAS bf16x8*)(lds + PG8_SA(b, h) + aoff + m * 2048 + k * 1024); } while (0)
#define PG8_LDB(dst, b, h) do { _Pragma("unroll") for (int n = 0; n < 2; ++n) _Pragma("unroll") for (int k = 0; k < 2; ++k) dst[n][k] = *(const PG8_LAS bf16x8*)(lds + PG8_SB(b, h) + boff + n * 2048 + k * 1024); } while (0)
#define PG8_MMA(ai, bj, At, Bt) do { __builtin_amdgcn_s_setprio(1); _Pragma("unroll") for (int m = 0; m < 4; ++m) _Pragma("unroll") for (int n = 0; n < 2; ++n) _Pragma("unroll") for (int k = 0; k < 2; ++k) \
        acc[ai][bj][m][n] = __builtin_amdgcn_mfma_f32_16x16x32_bf16(Bt[n][k], At[m][k], acc[ai][bj][m][n], 0, 0, 0); __builtin_amdgcn_s_setprio(0); } while (0)
#define PG8_WAIT_V(n) asm volatile("s_waitcnt vmcnt(" #n ")" ::: "memory")
#define PG8_WAIT_L(n) asm volatile("s_waitcnt lgkmcnt(" #n ")" ::: "memory")
#define PG8_BAR __builtin_amdgcn_s_barrier()
#define PG8_SCHED __builtin_amdgcn_sched_barrier(0)
    Unit cur, nxt; int ui = 0;
    if (!S.next(0, cur)) return;
    f32x4 acc[2][2][4][2];
#pragma unroll
    for (int a = 0; a < 2; ++a)
#pragma unroll
        for (int b = 0; b < 2; ++b)
#pragma unroll
            for (int m = 0; m < 4; ++m)
#pragma unroll
                for (int n = 0; n < 2; ++n) acc[a][b][m][n] = (f32x4){0.f, 0.f, 0.f, 0.f};
    bf16x8 At[4][2], B0[2][2], B1[2][2];
    const char* cA = (const char*)g.A + (size_t)cur.pm * tstep; const char* cB = (const char*)g.Bt + (size_t)cur.pn * tstep;
    S.a_ready(cur);
    if constexpr (SP2) {
        PG8_STAGE(PG8_SB(0, 0), cB, voffB); PG8_STAGE(PG8_SB(0, 1), cB + hstep, voffB); PG8_STAGE(PG8_SA(0, 0), cA, voffA); PG8_STAGE(PG8_SA(0, 1), cA + hstep, voffA);
        if (wr == 1) PG8_BAR;
        PG8_WAIT_V(2); PG8_BAR;
        PG8_STAGE(PG8_SB(1, 0), cB + kstep, voffB); PG8_STAGE(PG8_SA(1, 0), cA + kstep, voffA); PG8_STAGE(PG8_SB(1, 1), cB + hstep + kstep, voffB);
        PG8_WAIT_V(6); PG8_BAR;
    } else {
        PG8_STAGE(PG8_SB(0, 0), cB, voffB); PG8_STAGE(PG8_SA(0, 0), cA, voffA); PG8_STAGE(PG8_SB(0, 1), cB + hstep, voffB); PG8_STAGE(PG8_SA(0, 1), cA + hstep, voffA);
        if (wr == 1) PG8_BAR;
        PG8_WAIT_V(4); PG8_BAR;
        PG8_STAGE(PG8_SB(1, 0), cB + kstep, voffB); PG8_STAGE(PG8_SA(1, 0), cA + kstep, voffA); PG8_STAGE(PG8_SB(1, 1), cB + hstep + kstep, voffB);
        PG8_WAIT_V(6); PG8_BAR;
    }
    for (;;) {
        const bool has_next = S.next(ui + 1, nxt);
        const char* nA = has_next ? (const char*)g.A + (size_t)nxt.pm * tstep : cA; const char* nB = has_next ? (const char*)g.Bt + (size_t)nxt.pn * tstep : cB;
        for (int t = 0; t < nt; t += 2) {
            const bool last = (t == nt - 2);
            const char* a1 = cA + (size_t)(t + 1) * kstep;
            const char* a2 = last ? nA : cA + (size_t)(t + 2) * kstep; const char* b2 = last ? nB : cB + (size_t)(t + 2) * kstep;
            const char* a3 = a2 + kstep; const char* b3 = b2 + kstep;
            if (last && has_next) S.a_ready(nxt);
            if constexpr (SP2) {
            PG8_LDB(B0, 0, 0); PG8_LDB(B1, 0, 1); PG8_SCHED; PG8_LDA(At, 0, 0); PG8_STAGE(PG8_SA(1, 1), a1 + hstep, voffA);
            PG8_WAIT_V(8); PG8_WAIT_L(0); PG8_BAR; PG8_MMA(0, 0, At, B0); PG8_MMA(0, 1, At, B1); PG8_BAR; PG8_SCHED;
            PG8_LDA(At, 0, 1); PG8_STAGE(PG8_SB(0, 0), b2, voffB); PG8_STAGE(PG8_SB(0, 1), b2 + hstep, voffB); PG8_STAGE(PG8_SA(0, 0), a2, voffA);
            PG8_WAIT_V(8); PG8_WAIT_L(0); PG8_BAR; PG8_MMA(1, 0, At, B0); PG8_MMA(1, 1, At, B1); PG8_BAR; PG8_SCHED;
            PG8_LDB(B0, 1, 0); PG8_LDB(B1, 1, 1); PG8_SCHED; PG8_LDA(At, 1, 0); PG8_STAGE(PG8_SA(0, 1), a2 + hstep, voffA);
            PG8_WAIT_V(8); PG8_WAIT_L(0); PG8_BAR; PG8_MMA(0, 0, At, B0); PG8_MMA(0, 1, At, B1); PG8_BAR; PG8_SCHED;
            PG8_LDA(At, 1, 1); PG8_STAGE(PG8_SB(1, 0), b3, voffB); PG8_STAGE(PG8_SB(1, 1), b3 + hstep, voffB); PG8_STAGE(PG8_SA(1, 0), a3, voffA);
            PG8_WAIT_V(8); PG8_WAIT_L(0); PG8_BAR; PG8_MMA(1, 0, At, B0); PG8_MMA(1, 1, At, B1); PG8_BAR; PG8_SCHED;
            } else {
            PG8_LDB(B0, 0, 0); PG8_SCHED; PG8_LDA(At, 0, 0); PG8_STAGE(PG8_SA(1, 1), a1 + hstep, voffA);
            PG8_WAIT_L(8); PG8_BAR; PG8_WAIT_L(0); PG8_MMA(0, 0, At, B0); PG8_BAR; PG8_SCHED;
            PG8_LDB(B1, 0, 1); PG8_STAGE(PG8_SB(0, 0), b2, voffB);
            PG8_BAR; PG8_WAIT_L(0); PG8_MMA(0, 1, At, B1); PG8_BAR;
            PG8_LDA(At, 0, 1); PG8_STAGE(PG8_SA(0, 0), a2, voffA);
            PG8_BAR; PG8_WAIT_L(0); PG8_MMA(1, 0, At, B0); PG8_BAR; PG8_SCHED;
            PG8_STAGE(PG8_SB(0, 1), b2 + hstep, voffB);
            PG8_WAIT_V(6); PG8_BAR; PG8_MMA(1, 1, At, B1); PG8_BAR;
            PG8_LDB(B0, 1, 0); PG8_SCHED; PG8_LDA(At, 1, 0); PG8_STAGE(PG8_SA(0, 1), a2 + hstep, voffA);
            PG8_WAIT_L(8); PG8_BAR; PG8_WAIT_L(0); PG8_MMA(0, 0, At, B0); PG8_BAR; PG8_SCHED;
            PG8_LDB(B1, 1, 1); PG8_STAGE(PG8_SB(1, 0), b3, voffB);
            PG8_BAR; PG8_WAIT_L(0); PG8_MMA(0, 1, At, B1); PG8_BAR;
            PG8_LDA(At, 1, 1); PG8_STAGE(PG8_SA(1, 0), a3, voffA);
            PG8_BAR; PG8_WAIT_L(0); PG8_MMA(1, 0, At, B0); PG8_BAR; PG8_SCHED;
            PG8_STAGE(PG8_SB(1, 1), b3 + hstep, voffB);
            PG8_WAIT_V(6); PG8_BAR; PG8_MMA(1, 1, At, B1); PG8_BAR;
            }
        }
        if constexpr (ALIGN_EPI) { if (wr == 0) PG8_BAR; }
        if constexpr (!Epi::AFTER_DRAIN) { E(acc, cur, wr, wc, fr, fq); S.done(cur); }
        if (!has_next) break;
#pragma unroll
        for (int a = 0; a < 2; ++a)
#pragma unroll
            for (int b = 0; b < 2; ++b)
#pragma unroll
                for (int m = 0; m < 4; ++m)
#pragma unroll
                    for (int n = 0; n < 2; ++n) acc[a][b][m][n] = (f32x4){0.f, 0.f, 0.f, 0.f};
        cur = nxt; cA = nA; cB = nB; ++ui;
        if constexpr (ALIGN_EPI) { if (wr == 1) PG8_BAR; }
    }
    PG8_WAIT_V(0);
    if constexpr (!ALIGN_EPI) { if (wr == 0) PG8_BAR; }
    PG8_BAR;
    if constexpr (Epi::AFTER_DRAIN) { E.fused(acc, cur, wr, wc, fr, fq, lds, wid, lane); S.done(cur); }
    E.tail(acc, cur, wr, wc, fr, fq);
#undef PG8_SA
#undef PG8_SB
#undef PG8_STAGE
#undef PG8_LDA
#undef PG8_LDB
#undef PG8_MMA
#undef PG8_WAIT_V
#undef PG8_WAIT_L
#undef PG8_BAR
#undef PG8_SCHED
}
}

namespace cg = cooperative_groups;
using pg8::bf16_t; using pg8::f32x4; using pg8::u32x4; using pg8::Unit;
typedef unsigned u32x2 __attribute__((ext_vector_type(2)));
typedef float f32x2 __attribute__((ext_vector_type(2)));

constexpr int DM = 1024, SEQ = 8192, NBATCH = 2, CTXL = 256, DFF = 2816;
constexpr int MLAT = NBATCH * SEQ;
constexpr int MCTX = NBATCH * CTXL;
constexpr int MTOT = MLAT + MCTX;
constexpr int PN_LD = 1536;
constexpr float LOG2E = 1.4426950408889634f;
constexpr float NORM_EPS = 1e-6f;
constexpr int NCHUNK = 66;

constexpr size_t MiB = 1u << 20;
constexpr size_t OFF_BAR = 0;
constexpr size_t OFF_MOD = 1 * MiB;
constexpr size_t OFF_ROPE = 1 * MiB + 256 * 1024;
constexpr size_t OFF_TW = 1 * MiB + 320 * 1024;
constexpr size_t OFF_LG = 1 * MiB + 400 * 1024;
constexpr size_t OFF_HC = 2 * MiB;
constexpr size_t OFF_WFFIN = 4 * MiB;  constexpr size_t SZ_WFFIN = (size_t)2 * DFF * DM * 2;
constexpr size_t OFF_WFFOUT = 48 * MiB; constexpr size_t SZ_WFFOUT = (size_t)DM * DFF * 2;
constexpr size_t OFF_WO = 70 * MiB;    constexpr size_t SZ_WO = (size_t)DM * DM * 2;
constexpr size_t OFF_R = 74 * MiB;
constexpr int R_XN_ROWS = MTOT, R_LAYER_ROWS = 2560, R_N_ROWS = 1536;
constexpr size_t OFF_BIG = 118 * MiB;
constexpr size_t OFF_ACT = OFF_BIG;
constexpr size_t OFF_PN = OFF_BIG;
constexpr size_t OFF_GT = OFF_BIG + 50 * MiB;
constexpr size_t OFF_VT = OFF_BIG + 84 * MiB;
constexpr size_t OFF_YCAT = OFF_BIG + 101 * MiB;
constexpr size_t OFF_KV = OFF_BIG + 135 * MiB;
constexpr size_t OFF_XBUF = OFF_BIG + 152 * MiB;
constexpr size_t WS_NEED = OFF_BIG + 154 * MiB;
constexpr int LDS_BYTES = 147456;

struct Params {
    const float *x, *c, *ctx, *c_ctx, *norm_w, *w_ada, *b_ada, *ffn_w_in, *ffn_w_out, *w_in, *w_o, *ret_decay, *ret_gn_w, *attn_sink, *final_norm_w;
    float* out; unsigned char* ws;
};

__device__ __forceinline__ unsigned pk2(float lo, float hi) { return pg8::cvt_pk_bf16(lo, hi); }
typedef __bf16 bf16x2_c __attribute__((ext_vector_type(2)));
__device__ __forceinline__ unsigned cvtpk_c(float lo, float hi) { f32x2 v = {lo, hi}; bf16x2_c b = __builtin_convertvector(v, bf16x2_c); return __builtin_bit_cast(unsigned, b); }
__device__ __forceinline__ u32x4 widen16(u32x2 wa, u32x2 wb) { const auto rx = __builtin_amdgcn_permlane16_swap(wa.x, wb.x, false, false); const auto ry = __builtin_amdgcn_permlane16_swap(wa.y, wb.y, false, false); return (u32x4){rx[0], ry[0], rx[1], ry[1]}; }
__device__ __forceinline__ float bf_lo(unsigned w) { return __builtin_bit_cast(float, w << 16); }
__device__ __forceinline__ float bf_hi(unsigned w) { return __builtin_bit_cast(float, w & 0xffff0000u); }
__device__ __forceinline__ float fexp2(float x) { return __builtin_amdgcn_exp2f(x); }
__device__ __forceinline__ float frcp(float x) { return __builtin_amdgcn_rcpf(x); }
__device__ __forceinline__ float silu_f(float g) { return g * frcp(1.0f + fexp2(-g * LOG2E)); }
__device__ __forceinline__ float wave_sum(float v) {
#pragma unroll
    for (int o = 1; o < 64; o <<= 1) v += __shfl_xor(v, o);
    return v;
}
__device__ __forceinline__ float log2_sigmoid(float x) { const float ls = x >= 0.f ? -log1pf(expf(-x)) : x - log1pf(expf(x)); return ls * LOG2E; }

struct EpiSwiglu {
    static constexpr bool PERM = false, AFTER_DRAIN = false;
    bf16_t* O;
    __device__ __forceinline__ void operator()(const f32x4 (&acc)[2][2][4][2], const Unit& u, int wr, int wc, int fr, int fq) const {
        const int row0 = u.pm * 256 + wr * 64 + fr, col0 = u.pn * 128 + wc * 16 + 4 * (fq & ~1);
#pragma unroll
        for (int ai = 0; ai < 2; ++ai)
#pragma unroll
            for (int mp = 0; mp < 2; ++mp) { bf16_t* rowp = O + (size_t)(row0 + ai * 128 + (2 * mp + (fq & 1)) * 16) * DFF + col0;
#pragma unroll
                for (int bj = 0; bj < 2; ++bj) {
                    const f32x4 g0 = acc[ai][bj][2 * mp][0], u0 = acc[ai][bj][2 * mp][1], g1 = acc[ai][bj][2 * mp + 1][0], u1 = acc[ai][bj][2 * mp + 1][1];
                    const unsigned ax = cvtpk_c(silu_f(g0[0]) * u0[0], silu_f(g0[1]) * u0[1]), ay = cvtpk_c(silu_f(g0[2]) * u0[2], silu_f(g0[3]) * u0[3]);
                    const unsigned bx = cvtpk_c(silu_f(g1[0]) * u1[0], silu_f(g1[1]) * u1[1]), by = cvtpk_c(silu_f(g1[2]) * u1[2], silu_f(g1[3]) * u1[3]);
                    const auto rx = __builtin_amdgcn_permlane16_swap(ax, bx, false, false); const auto ry = __builtin_amdgcn_permlane16_swap(ay, by, false, false);
                    *(u32x4*)(rowp + bj * 64) = (u32x4){rx[0], ry[0], rx[1], ry[1]}; }
                asm volatile("" ::: "memory"); }
    }
};
struct EpiResid {
    static constexpr bool PERM = false, AFTER_DRAIN = false;
    const float* src_lat; const float* src_ctx; float* dst_lat; float* dst_ctx; const float* modv; float sc;
    __device__ __forceinline__ void operator()(const f32x4 (&acc)[2][2][4][2], const Unit& u, int wr, int wc, int fr, int fq) const {
        const int set = u.pm < 32 ? 0 : (u.pm < 64 ? 1 : 2);
        const float* mv = modv + (size_t)set * 9 * DM;
        const bool lat = u.pm < 64;
        const int rbase = lat ? u.pm * 256 : u.pm * 256 - MLAT;
        const float* src = lat ? src_lat : src_ctx; float* dst = lat ? dst_lat : dst_ctx;
        const int col0 = u.pn * 256 + wc * 32 + 4 * fq;
        f32x4 mvv[2][2];
#pragma unroll
        for (int bj = 0; bj < 2; ++bj)
#pragma unroll
            for (int n = 0; n < 2; ++n) mvv[bj][n] = *(const f32x4*)(mv + col0 + bj * 128 + n * 16) * sc;
#pragma unroll
        for (int ai = 0; ai < 2; ++ai)
#pragma unroll
            for (int m = 0; m < 4; ++m) { const size_t off = (size_t)(rbase + ai * 128 + wr * 64 + m * 16 + fr) * DM + col0;
#pragma unroll
                for (int bj = 0; bj < 2; ++bj)
#pragma unroll
                    for (int n = 0; n < 2; ++n) { const f32x4 s = *(const f32x4*)(src + off + bj * 128 + n * 16);
                        *(f32x4*)(dst + off + bj * 128 + n * 16) = s + mvv[bj][n] * acc[ai][bj][m][n]; }
                if (m == 3) asm volatile("" ::: "memory"); }
    }
};
__device__ __forceinline__ void epi_resid_norm(f32x4 (&acc)[2][2][4][2], const Unit& u, int wr, int wc, int fr, int fq,
        const float* src_lat, const float* src_ctx, float* dst_lat, float* dst_ctx, const float* modv, float sc,
        const float* nw, const float* mshift, const float* mscale, bf16_t* XN, float* xbuf, unsigned* cnt, LAS unsigned char* xl, const float* fw) {
    {
        const int set = u.pm < 32 ? 0 : (u.pm < 64 ? 1 : 2);
        const float* mv = modv + (size_t)set * 9 * DM;
        const bool lat = u.pm < 64;
        const int rbase = lat ? u.pm * 256 : u.pm * 256 - MLAT;
        const float* src = lat ? src_lat : src_ctx; float* dst = lat ? dst_lat : dst_ctx;
        const int col0 = u.pn * 256 + wc * 32 + 4 * fq;
        LAS float* P = (LAS float*)xl; LAS float* S = (LAS float*)(xl + 4096);
        {   f32x4 mvv[2][2];
#pragma unroll
            for (int bj = 0; bj < 2; ++bj)
#pragma unroll
                for (int n = 0; n < 2; ++n) mvv[bj][n] = *(const f32x4*)(mv + col0 + bj * 128 + n * 16) * sc;
#pragma unroll
            for (int ai = 0; ai < 2; ++ai)
#pragma unroll
                for (int m = 0; m < 4; ++m) { const size_t off = (size_t)(rbase + ai * 128 + wr * 64 + m * 16 + fr) * DM + col0; float q = 0.f;
#pragma unroll
                    for (int bj = 0; bj < 2; ++bj)
#pragma unroll
                        for (int n = 0; n < 2; ++n) { const f32x4 s = *(const f32x4*)(src + off + bj * 128 + n * 16); const f32x4 v = s + mvv[bj][n] * acc[ai][bj][m][n];
                            if (fw == nullptr) *(f32x4*)(dst + off + bj * 128 + n * 16) = v;
                            acc[ai][bj][m][n] = v; q += (v[0] * v[0] + v[1] * v[1]) + (v[2] * v[2] + v[3] * v[3]); }
                    q += __shfl_xor(q, 16); q += __shfl_xor(q, 32);
                    if (fq == 0) P[(ai * 128 + wr * 64 + m * 16 + fr) * 4 + wc] = q;
                    if (m & 1) asm volatile("" ::: "memory"); }
        }
        asm volatile("s_waitcnt lgkmcnt(0)" ::: "memory"); __builtin_amdgcn_s_barrier(); asm volatile("" ::: "memory");
        const int tid = tidx(), lane = tid & 63, wid = tid >> 6, row = wid * 32 + (lane & 31);
        if (lane < 32) { const f32x4 p = *(const LAS f32x4*)(P + row * 4);
            __hip_atomic_store(xbuf + (size_t)(u.pm * 256 + row) * 4 + u.pn, (p[0] + p[1]) + (p[2] + p[3]), __ATOMIC_RELAXED, __HIP_MEMORY_SCOPE_AGENT); }
        asm volatile("s_waitcnt vmcnt(0)" ::: "memory");
        if (lane == 0) __hip_atomic_fetch_add(cnt + 64 * u.pm, 1u, __ATOMIC_RELAXED, __HIP_MEMORY_SCOPE_AGENT);
        if (wid == 0) { unsigned sp = 0;
            while ((unsigned)__builtin_amdgcn_readfirstlane(__hip_atomic_load(cnt + 64 * u.pm, __ATOMIC_RELAXED, __HIP_MEMORY_SCOPE_AGENT)) < 32u) { __builtin_amdgcn_s_sleep(2); if (++sp > (1u << 22)) break; }
            __builtin_amdgcn_fence(__ATOMIC_ACQUIRE, "agent"); }
        asm volatile("s_waitcnt vmcnt(0) lgkmcnt(0)" ::: "memory"); __builtin_amdgcn_s_barrier(); asm volatile("" ::: "memory");
        if (lane < 32) { const float* sl = xbuf + (size_t)(u.pm * 256 + row) * 4; float t = 0.f;
#pragma unroll
            for (int k = 0; k < 4; ++k) t += __hip_atomic_load(sl + k, __ATOMIC_RELAXED, __HIP_MEMORY_SCOPE_AGENT);
            S[row] = 1.0f / sqrtf(t * (1.0f / DM) + NORM_EPS); }
        asm volatile("s_waitcnt lgkmcnt(0)" ::: "memory"); __builtin_amdgcn_s_barrier(); asm volatile("" ::: "memory");
        const float* shp = mshift + (size_t)set * 9 * DM + col0; const float* scp = mscale + (size_t)set * 9 * DM + col0; const float* nwp = nw + col0;
#pragma unroll
        for (int ai = 0; ai < 2; ++ai)
#pragma unroll
            for (int mp = 0; mp < 2; ++mp) { const int rl0 = ai * 128 + wr * 64 + (2 * mp) * 16 + fr; const float rstd0 = S[rl0], rstd1 = S[rl0 + 16];
                if (fw != nullptr) {
#pragma unroll
                    for (int mo = 0; mo < 2; ++mo)
#pragma unroll
                        for (int bj = 0; bj < 2; ++bj)
#pragma unroll
                            for (int n = 0; n < 2; ++n) { const int co = bj * 128 + n * 16;
                                *(f32x4*)(dst + (size_t)(rbase + rl0 + 16 * mo) * DM + col0 + co) = acc[ai][bj][2 * mp + mo][n] * (mo ? rstd1 : rstd0) * *(const f32x4*)(fw + col0 + co); }
                } else {
                    bf16_t* xo = XN + (size_t)(u.pm * 256 + rl0 + (fq & 1) * 16) * DM + u.pn * 256 + wc * 32 + 4 * (fq & ~1);
#pragma unroll
                    for (int bj = 0; bj < 2; ++bj)
#pragma unroll
                        for (int n = 0; n < 2; ++n) { const int co = bj * 128 + n * 16;
                            const f32x4 gg = *(const f32x4*)(nwp + co) * (*(const f32x4*)(scp + co) + 1.0f); const f32x4 sh = *(const f32x4*)(shp + co);
                            const f32x4 y0 = acc[ai][bj][2 * mp][n] * rstd0 * gg + sh, y1 = acc[ai][bj][2 * mp + 1][n] * rstd1 * gg + sh;
                            *(u32x4*)(xo + co) = widen16((u32x2){cvtpk_c(y0[0], y0[1]), cvtpk_c(y0[2], y0[3])}, (u32x2){cvtpk_c(y1[0], y1[1]), cvtpk_c(y1[2], y1[3])}); }
                }
                asm volatile("" ::: "memory"); }
    }
}
struct EpiInProj {
    static constexpr bool PERM = false, AFTER_DRAIN = false;
    bf16_t* PN; float* GT; bf16_t* VT; const float* rope; int ntile0, ttile0;
    __device__ __forceinline__ void operator()(const f32x4 (&acc)[2][2][4][2], const Unit& u, int wr, int wc, int fr, int fq) const {
        if (u.pm < 66) {
            const int j = u.pn - ntile0;
            const bool do_rope = (j != 2) && (u.pm < 64);
            const float scl = (j == 1) ? 0.125f : ((j == 3 || j == 4) ? 0.125f * LOG2E : 1.0f);
#pragma unroll
            for (int ai = 0; ai < 2; ++ai)
#pragma unroll
                for (int mp = 0; mp < 2; ++mp) {
                    u32x2 w1[2][2], w2[2][2];
#pragma unroll
                    for (int mo = 0; mo < 2; ++mo) { const int m = 2 * mp + mo;
                        const int r = u.pm * 256 + ai * 128 + wr * 64 + m * 16 + fr;
                        f32x4 ca = {1.f, 0.f, 1.f, 0.f}, cb = {1.f, 0.f, 1.f, 0.f};
                        if (do_rope) { const int t = r & (SEQ - 1); const int pos = (wc & 1) ? (t & 63) : (t >> 6);
                            const float* rp = rope + (size_t)(pos * 16 + 4 * fq) * 2; ca = *(const f32x4*)rp; cb = *(const f32x4*)(rp + 4); }
#pragma unroll
                        for (int bj = 0; bj < 2; ++bj) { const f32x4 x1 = acc[ai][bj][m][0], x2 = acc[ai][bj][m][1];
                            f32x4 o1, o2;
                            o1[0] = x1[0] * ca[0] - x2[0] * ca[1]; o2[0] = x2[0] * ca[0] + x1[0] * ca[1];
                            o1[1] = x1[1] * ca[2] - x2[1] * ca[3]; o2[1] = x2[1] * ca[2] + x1[1] * ca[3];
                            o1[2] = x1[2] * cb[0] - x2[2] * cb[1]; o2[2] = x2[2] * cb[0] + x1[2] * cb[1];
                            o1[3] = x1[3] * cb[2] - x2[3] * cb[3]; o2[3] = x2[3] * cb[2] + x1[3] * cb[3];
                            o1 = o1 * scl; o2 = o2 * scl;
                            w1[mo][bj] = (u32x2){cvtpk_c(o1[0], o1[1]), cvtpk_c(o1[2], o1[3])}; w2[mo][bj] = (u32x2){cvtpk_c(o2[0], o2[1]), cvtpk_c(o2[2], o2[3])}; } }
                    bf16_t* rowp = PN + (size_t)(u.pm * 256 + ai * 128 + wr * 64 + (2 * mp + (fq & 1)) * 16 + fr) * PN_LD + j * 256 + wc * 32 + 4 * (fq & ~1);
#pragma unroll
                    for (int bj = 0; bj < 2; ++bj) { if (j == 5 && bj == 1) continue;
                        *(u32x4*)(rowp + bj * 128) = widen16(w1[0][bj], w1[1][bj]); *(u32x4*)(rowp + bj * 128 + 16) = widen16(w2[0][bj], w2[1][bj]); }
                    asm volatile("" ::: "memory");
                }
        } else {
            const int jt = u.pm - ttile0;
            const int tok0 = u.pn * 256 + wc * 32 + 4 * fq;
#pragma unroll
            for (int ai = 0; ai < 2; ++ai)
#pragma unroll
                for (int m = 0; m < 4; ++m) {
                    const int f = jt * 256 + ai * 128 + wr * 64 + m * 16 + fr;
                    if (jt < 2) { float* rowp = GT + (size_t)f * MTOT + tok0;
                        const int bin = 16 * m + fr;
                        const bool need = (wr == 0) ? (bin <= 32) : (bin >= 1 && bin <= 31);
                        if (need) {
#pragma unroll
                        for (int bj = 0; bj < 2; ++bj)
#pragma unroll
                            for (int n = 0; n < 2; ++n) *(f32x4*)(rowp + bj * 128 + n * 16) = acc[ai][bj][m][n]; }
                    } else if ((m & 1) == 0 && !(jt == 3 && ai == 1)) {
                        bf16_t* rowp = VT + (size_t)(f + (fq & 1) * 16 - 512) * MTOT + u.pn * 256 + wc * 32 + 4 * (fq & ~1);
#pragma unroll
                        for (int bj = 0; bj < 2; ++bj)
#pragma unroll
                            for (int n = 0; n < 2; ++n) { const f32x4 va = acc[ai][bj][m][n], vb = acc[ai][bj][m + 1][n];
                                *(u32x4*)(rowp + bj * 128 + n * 16) = widen16((u32x2){cvtpk_c(va[0], va[1]), cvtpk_c(va[2], va[3])}, (u32x2){cvtpk_c(vb[0], vb[1]), cvtpk_c(vb[2], vb[3])}); }
                    }
                }
        }
    }
};
struct InSched {
    int G, c, ntile0, ttile0;
    __device__ __forceinline__ bool next(int i, Unit& u) const {
        int tok, j;
        if (G == 256) { const int x = c & 7, n = i * 32 + (c >> 3), k = n / 10; tok = x + 8 * k; j = n - 10 * k; if (tok >= 66) return false; }
        else { const int L = i * G + c; if (L >= 660) return false; tok = L / 10; j = L % 10; }
        if (j < 6) { u.pm = tok; u.pn = ntile0 + j; } else { u.pm = ttile0 + (j - 6); u.pn = tok; }
        return true;
    }
    __device__ __forceinline__ void a_ready(const Unit&) const {}
    __device__ __forceinline__ void done(const Unit&) const {}
};

__device__ __forceinline__ bf16_t* dest_rowptr(int kind, int idx, int n, unsigned char* ws) {
    if (kind == 0) { const int half = n >= DFF ? 1 : 0; const int jj = n - half * DFF; const int row = 32 * (jj >> 4) + 16 * half + (jj & 15);
        return (bf16_t*)(ws + OFF_WFFIN + (size_t)idx * SZ_WFFIN) + (size_t)row * DM; }
    if (kind == 1) return (bf16_t*)(ws + OFF_WFFOUT + (size_t)idx * SZ_WFFOUT) + (size_t)n * DFF;
    if (kind == 2) return (bf16_t*)(ws + OFF_WO + (size_t)idx * SZ_WO) + (size_t)n * DM;
    const int rn = R_XN_ROWS + R_LAYER_ROWS * idx, rt = rn + R_N_ROWS; int row;
    if (n < 512) row = rn + (n - 256);
    else if (n < 768) row = rn + 256 + (n - 512);
    else if (n < 1024) row = rt + 512 + (n - 768);
    else if (n < 1280) row = rn + 512 + (n - 1024);
    else if (n < 1792) row = rn + 768 + (n - 1280);
    else if (n < 1920) row = rn + 1280 + (n - 1792);
    else row = rt + 768 + (n - 1920);
    return (bf16_t*)(ws + OFF_R) + (size_t)row * DM;
}
__device__ __forceinline__ void transpose_item(const float* W, int N, int k0, int n0, int kind, int idx, unsigned char* ws, LAS float* scr, int lane) {
    const int ks = lane >> 4, n4 = (lane & 15) * 4;
#pragma unroll
    for (int i = 0; i < 16; ++i) { const int kk = 4 * i + ks; const f32x4 v = __builtin_nontemporal_load((const f32x4*)(W + (size_t)(k0 + kk) * N + n0 + n4));
        LAS float* d = scr + kk * 65 + n4; d[0] = v[0]; d[1] = v[1]; d[2] = v[2]; d[3] = v[3]; }
    asm volatile("s_waitcnt lgkmcnt(0)" ::: "memory");
    const int c = lane & 7;
    const bool kperm = (kind == 2) && (k0 < 256);
#pragma unroll
    for (int j = 0; j < 8; ++j) { const int n = (lane >> 3) + 8 * j; const LAS float* s = scr + n;
        int kk[8];
#pragma unroll
        for (int e = 0; e < 8; ++e) { const int q = 8 * c + e; kk[e] = kperm ? (q == 0 ? 0 : (q == 1 ? 32 : ((q & 1) ? 64 - (q >> 1) : (q >> 1)))) : q; }
        u32x4 o; o.x = pk2(s[kk[0] * 65], s[kk[1] * 65]); o.y = pk2(s[kk[2] * 65], s[kk[3] * 65]); o.z = pk2(s[kk[4] * 65], s[kk[5] * 65]); o.w = pk2(s[kk[6] * 65], s[kk[7] * 65]);
        *(u32x4*)(dest_rowptr(kind, idx, n0 + n, ws) + k0 + 8 * c) = o; }
    asm volatile("s_waitcnt lgkmcnt(0)" ::: "memory");
}

template <class PP> __device__ __forceinline__ void p0_prologue(const PP& P, LAS unsigned char* lds) {
    const int tid = tidx(), lane = tid & 63, wave = __builtin_amdgcn_readfirstlane(tid >> 6);
    const int G = gdim(), bx = bidx();
    unsigned char* ws = P.ws;
    __syncthreads();
    LAS float* cond_s = (LAS float*)(lds + 73728);
    LAS float* red = (LAS float*)(lds + 86016);
    LAS f32x2* cs64 = (LAS f32x2*)(lds + 110592);
    for (int i = tid; i < 3 * DM; i += 512) { const int s = i >> 10, k = i & 1023; const float v = s < 2 ? P.c[s * DM + k] : P.c_ctx[k]; cond_s[i] = v / (1.0f + expf(-v)); }
    if (tid < 64) { float sn, cn; sincospif((float)tid / 32.0f, &sn, &cn); cs64[tid] = (f32x2){cn, sn}; }
    __syncthreads();
    float* MOD = (float*)(ws + OFF_MOD);
    for (int item = bx; item < 144; item += G) {
        const int L = item / 72, n0 = (item % 72) * 128;
        const float* W = P.w_ada + (size_t)L * DM * 9216 + n0 + 2 * lane;
        f32x2 a0 = {0.f, 0.f}, a1 = a0, a2 = a0;
#pragma unroll 8
        for (int kk = 0; kk < 128; ++kk) { const int k = wave * 128 + kk; const f32x2 w = __builtin_nontemporal_load((const f32x2*)(W + (size_t)k * 9216)); a0 += w * cond_s[k]; a1 += w * cond_s[1024 + k]; a2 += w * cond_s[2048 + k]; }
        *(LAS f32x2*)(red + (wave * 3 + 0) * 128 + 2 * lane) = a0; *(LAS f32x2*)(red + (wave * 3 + 1) * 128 + 2 * lane) = a1; *(LAS f32x2*)(red + (wave * 3 + 2) * 128 + 2 * lane) = a2;
        __syncthreads();
        if (tid < 384) { const int s = tid >> 7, l = tid & 127; float t = P.b_ada[L * 9216 + n0 + l];
#pragma unroll
            for (int w = 0; w < 8; ++w) t += red[(w * 3 + s) * 128 + l];
            MOD[(size_t)(L * 3 + s) * 9216 + n0 + l] = t; }
        __syncthreads();
    }
    for (int item = bx; item < 256; item += G) {
        const int L = item >> 7, g = (item >> 5) & 3, k = ((item >> 4) & 1) * 512 + tid, m0 = (item & 15) * 4;
        const float* wrow = P.w_in + ((size_t)L * DM + k) * 2048 + g * 64;
        float w[64];
#pragma unroll
        for (int c4 = 0; c4 < 16; ++c4) { const f32x4 v = *(const f32x4*)(wrow + 4 * c4); w[4 * c4] = v[0]; w[4 * c4 + 1] = v[1]; w[4 * c4 + 2] = v[2]; w[4 * c4 + 3] = v[3]; }
        bf16_t* Rb = (bf16_t*)(ws + OFF_R) + (size_t)(R_XN_ROWS + R_LAYER_ROWS * L + R_N_ROWS + g * 128) * DM + k;
        for (int m = m0; m < m0 + 4; ++m) {
            float re = 0.f, im = 0.f;
#pragma unroll
            for (int c = 0; c < 64; ++c) { const f32x2 t = cs64[(m * c) & 63]; re += w[c] * t.x; im -= w[c] * t.y; }
            Rb[(size_t)m * DM] = (bf16_t)(pk2(re, 0.f) & 0xffffu); Rb[(size_t)(64 + m) * DM] = (bf16_t)(pk2(im, 0.f) & 0xffffu);
        }
    }
    __syncthreads();
    {
        LAS float* scr = (LAS float*)(lds + wave * 16640);
        const int gw = bx * 8 + wave, NGW = G * 8;
        constexpr int I0 = 4 * 16 * 88, I1 = 4 * 44 * 16, I2 = 2 * 16 * 16, I3 = 2 * 16 * 28;
        for (int it = gw; it < I0 + I1 + I2 + I3; it += NGW) {
            int r = it;
            if (r < I0) { const int idx = r / (16 * 88), q = r % (16 * 88); transpose_item(P.ffn_w_in + (size_t)idx * DM * 2 * DFF, 2 * DFF, (q / 88) * 64, (q % 88) * 64, 0, idx, ws, scr, lane); continue; } r -= I0;
            if (r < I1) { const int idx = r / (44 * 16), q = r % (44 * 16); transpose_item(P.ffn_w_out + (size_t)idx * DFF * DM, DM, (q / 16) * 64, (q % 16) * 64, 1, idx, ws, scr, lane); continue; } r -= I1;
            if (r < I2) { const int idx = r / (16 * 16), q = r % (16 * 16); transpose_item(P.w_o + (size_t)idx * DM * DM, DM, (q / 16) * 64, (q % 16) * 64, 2, idx, ws, scr, lane); continue; } r -= I2;
            { const int idx = r / (16 * 28), q = r % (16 * 28); transpose_item(P.w_in + (size_t)idx * DM * 2048, 2048, (q / 28) * 64, (4 + q % 28) * 64, 3, idx, ws, scr, lane); }
        }
    }
    {
        const int gt = bx * 512 + tid, NGT = G * 512;
        f32x2* rope = (f32x2*)(ws + OFF_ROPE); f32x2* tw = (f32x2*)(ws + OFF_TW);
        if (gt < 16) ((float*)(ws + OFF_LG))[gt] = log2_sigmoid(P.ret_decay[gt]);
        for (int i = gt; i < 2048; i += NGT) { const int pos = i >> 4, p = i & 15; const float inv = exp2f(-(float)p * (13.287712379549449f / 16.0f)); const float ang = (float)pos * inv; float sn, cn; sincosf(ang, &sn, &cn); rope[i] = (f32x2){cn, sn}; }
        for (int i = gt; i < 8191; i += NGT) { int st = 0; while (i >= 8192 - (8192 >> (st + 1))) ++st; const int j = i - (8192 - (8192 >> st));
            float sn, cn; sincospif((float)(j << st) / 4096.0f, &sn, &cn); tw[i] = (f32x2){cn, -sn}; }
        for (int i = gt; i < 2 * 32768; i += NGT) { const int L = i >> 15, q = i & 32767, rr = q >> 7, piece = q & 127;
            const int row = R_XN_ROWS + R_LAYER_ROWS * L + (rr < 128 ? 1408 + rr : R_N_ROWS + 896 + (rr - 128));
            unsigned zz = 0u; asm volatile("" : "+v"(zz));
            *(u32x4*)((bf16_t*)(ws + OFF_R) + (size_t)row * DM + piece * 8) = (u32x4){zz, zz, zz, zz}; }
    }
}

__device__ __forceinline__ void norm_phase(const float* src_lat, const float* src_ctx, const float* nw, const float* mod_shift, const float* mod_scale, bf16_t* XN, int nrows) {
    const int tid = tidx(), lane = tid & 63, wave = tid >> 6;
    const int gw = bidx() * 8 + wave, NGW = gdim() * 8;
    f32x4 wv[4];
#pragma unroll
    for (int j = 0; j < 4; ++j) wv[j] = *(const f32x4*)(nw + 4 * lane + 256 * j);
    for (int r = gw; r < nrows; r += NGW) {
        const float* xr = r < MLAT ? src_lat + (size_t)r * DM : src_ctx + (size_t)(r - MLAT) * DM;
        const int set = r < SEQ ? 0 : (r < MLAT ? 1 : 2);
        f32x4 v[4]; float s = 0.f;
#pragma unroll
        for (int j = 0; j < 4; ++j) { v[j] = *(const f32x4*)(xr + 4 * lane + 256 * j); s += (v[j][0] * v[j][0] + v[j][1] * v[j][1]) + (v[j][2] * v[j][2] + v[j][3] * v[j][3]); }
        const float rstd = 1.0f / sqrtf(wave_sum(s) * (1.0f / DM) + NORM_EPS);
        bf16_t* orow = XN + (size_t)r * DM;
#pragma unroll
        for (int j = 0; j < 4; ++j) { const f32x4 sh = *(const f32x4*)(mod_shift + (size_t)set * 9 * DM + 4 * lane + 256 * j), sc = *(const f32x4*)(mod_scale + (size_t)set * 9 * DM + 4 * lane + 256 * j);
            const f32x4 y = v[j] * rstd * wv[j] * (sc + 1.0f) + sh;
            u32x2 w; w.x = pk2(y[0], y[1]); w.y = pk2(y[2], y[3]); *(u32x2*)(orow + 4 * lane + 256 * j) = w; }
    }
}
__device__ __forceinline__ void norm_rows(const float* src_lat, const float* src_ctx, const float* nw, const float* mod_shift, const float* mod_scale, bf16_t* XN, int r0, int nr) {
    const int tid = tidx(), lane = tid & 63, wave = tid >> 6;
    f32x4 wv[4];
#pragma unroll
    for (int j = 0; j < 4; ++j) wv[j] = *(const f32x4*)(nw + 4 * lane + 256 * j);
    for (int r = r0 + wave; r < r0 + nr; r += 8) {
        const float* xr = r < MLAT ? src_lat + (size_t)r * DM : src_ctx + (size_t)(r - MLAT) * DM;
        const int set = r < SEQ ? 0 : (r < MLAT ? 1 : 2);
        f32x4 v[4]; float s = 0.f;
#pragma unroll
        for (int j = 0; j < 4; ++j) { v[j] = *(const f32x4*)(xr + 4 * lane + 256 * j); s += (v[j][0] * v[j][0] + v[j][1] * v[j][1]) + (v[j][2] * v[j][2] + v[j][3] * v[j][3]); }
        const float rstd = 1.0f / sqrtf(wave_sum(s) * (1.0f / DM) + NORM_EPS);
        bf16_t* orow = XN + (size_t)r * DM;
#pragma unroll
        for (int j = 0; j < 4; ++j) { const f32x4 sh = *(const f32x4*)(mod_shift + (size_t)set * 9 * DM + 4 * lane + 256 * j), sc = *(const f32x4*)(mod_scale + (size_t)set * 9 * DM + 4 * lane + 256 * j);
            const f32x4 y = v[j] * rstd * wv[j] * (sc + 1.0f) + sh;
            u32x2 w; w.x = pk2(y[0], y[1]); w.y = pk2(y[2], y[3]); *(u32x2*)(orow + 4 * lane + 256 * j) = w; }
    }
}
__device__ __forceinline__ void final_norm_rows(float* out, const float* fw, int r0, int nr) {
    const int tid = tidx(), lane = tid & 63, wave = tid >> 6;
    f32x4 wv[4];
#pragma unroll
    for (int j = 0; j < 4; ++j) wv[j] = *(const f32x4*)(fw + 4 * lane + 256 * j);
    for (int r = r0 + wave; r < r0 + nr; r += 8) {
        float* xr = out + (size_t)r * DM;
        f32x4 v[4]; float s = 0.f;
#pragma unroll
        for (int j = 0; j < 4; ++j) { v[j] = *(const f32x4*)(xr + 4 * lane + 256 * j); s += (v[j][0] * v[j][0] + v[j][1] * v[j][1]) + (v[j][2] * v[j][2] + v[j][3] * v[j][3]); }
        const float rstd = 1.0f / sqrtf(wave_sum(s) * (1.0f / DM) + NORM_EPS);
#pragma unroll
        for (int j = 0; j < 4; ++j) *(f32x4*)(xr + 4 * lane + 256 * j) = v[j] * rstd * wv[j];
    }
}
__device__ __forceinline__ void final_norm_phase(float* out, const float* fw) {
    const int tid = tidx(), lane = tid & 63, wave = tid >> 6;
    const int gw = bidx() * 8 + wave, NGW = gdim() * 8;
    f32x4 wv[4];
#pragma unroll
    for (int j = 0; j < 4; ++j) wv[j] = *(const f32x4*)(fw + 4 * lane + 256 * j);
    for (int r = gw; r < MLAT; r += NGW) {
        float* xr = out + (size_t)r * DM;
        f32x4 v[4]; float s = 0.f;
#pragma unroll
        for (int j = 0; j < 4; ++j) { v[j] = *(const f32x4*)(xr + 4 * lane + 256 * j); s += (v[j][0] * v[j][0] + v[j][1] * v[j][1]) + (v[j][2] * v[j][2] + v[j][3] * v[j][3]); }
        const float rstd = 1.0f / sqrtf(wave_sum(s) * (1.0f / DM) + NORM_EPS);
#pragma unroll
        for (int j = 0; j < 4; ++j) *(f32x4*)(xr + 4 * lane + 256 * j) = v[j] * rstd * wv[j];
    }
}

__device__ __forceinline__ int chunk_row0(int b, int c) { return c < 64 ? b * SEQ + 128 * c : MLAT + b * CTXL + 128 * (c - 64); }

__device__ __forceinline__ void stage_rows_f32(const bf16_t* src, int ld, LAS float* dst, int tid) {
    const int j = tid >> 2, d0 = (tid & 3) * 16;
    const u32x4 a = *(const u32x4*)(src + (size_t)j * ld + d0), b = *(const u32x4*)(src + (size_t)j * ld + d0 + 8);
    LAS f32x4* o = (LAS f32x4*)(dst + j * 64 + d0);
    o[0] = (f32x4){bf_lo(a.x), bf_hi(a.x), bf_lo(a.y), bf_hi(a.y)}; o[1] = (f32x4){bf_lo(a.z), bf_hi(a.z), bf_lo(a.w), bf_hi(a.w)};
    o[2] = (f32x4){bf_lo(b.x), bf_hi(b.x), bf_lo(b.y), bf_hi(b.y)}; o[3] = (f32x4){bf_lo(b.z), bf_hi(b.z), bf_lo(b.w), bf_hi(b.w)};
}
__device__ __forceinline__ void stage_cols_f32(const bf16_t* src, LAS float* dst, int tid) {
    const int d = tid >> 3, j0 = (tid & 7) * 16;
    const u32x4 a = *(const u32x4*)(src + (size_t)d * MTOT + j0), b = *(const u32x4*)(src + (size_t)d * MTOT + j0 + 8);
    LAS float* o = dst + j0 * 64 + d;
    o[0 * 64] = bf_lo(a.x); o[1 * 64] = bf_hi(a.x); o[2 * 64] = bf_lo(a.y); o[3 * 64] = bf_hi(a.y); o[4 * 64] = bf_lo(a.z); o[5 * 64] = bf_hi(a.z); o[6 * 64] = bf_lo(a.w); o[7 * 64] = bf_hi(a.w);
    o[8 * 64] = bf_lo(b.x); o[9 * 64] = bf_hi(b.x); o[10 * 64] = bf_lo(b.y); o[11 * 64] = bf_hi(b.y); o[12 * 64] = bf_lo(b.z); o[13 * 64] = bf_hi(b.z); o[14 * 64] = bf_lo(b.w); o[15 * 64] = bf_hi(b.w);
}

__device__ __forceinline__ void attn_unit(const bf16_t* PN, const bf16_t* VT, bf16_t* YC, const float* sink, LAS unsigned char* lds, int b, int kvh, int qt, bool isctx) {
    const int tid = tidx(), i = tid & 127, g = tid >> 7, head = kvh * 4 + g;
    LAS float* Ks = (LAS float*)lds; LAS float* Vs = (LAS float*)(lds + 32768);
    const int row0 = isctx ? MLAT + b * CTXL + 128 * qt : b * SEQ + 128 * qt;
    float q[64], o[64];
    { const bf16_t* qp = PN + (size_t)(row0 + i) * PN_LD + 768 + head * 64;
#pragma unroll
      for (int c8 = 0; c8 < 8; ++c8) { const u32x4 a = *(const u32x4*)(qp + 8 * c8);
          q[8 * c8] = bf_lo(a.x); q[8 * c8 + 1] = bf_hi(a.x); q[8 * c8 + 2] = bf_lo(a.y); q[8 * c8 + 3] = bf_hi(a.y); q[8 * c8 + 4] = bf_lo(a.z); q[8 * c8 + 5] = bf_hi(a.z); q[8 * c8 + 6] = bf_lo(a.w); q[8 * c8 + 7] = bf_hi(a.w); } }
#pragma unroll
    for (int d = 0; d < 64; ++d) o[d] = 0.f;
    float mx = sink[head] * LOG2E, l = 1.0f;
    for (int ch = 0; ch < 5; ++ch) {
        int krow0;
        if (ch < 3) { if (isctx) continue; const int kb = qt - 1 + ch; if (kb < 0 || kb >= 64) continue; krow0 = b * SEQ + 128 * kb; }
        else krow0 = MLAT + b * CTXL + 128 * (ch - 3);
        __syncthreads();
        stage_rows_f32(PN + (size_t)krow0 * PN_LD + 1280 + kvh * 64, PN_LD, Ks, tid);
        stage_cols_f32(VT + (size_t)(256 + kvh * 64) * MTOT + krow0, Vs, tid);
        __syncthreads();
        for (int j = 0; j < 128; ++j) {
            const bool valid = (ch == 0) ? (j >= i) : ((ch == 2) ? (j <= i) : true);
            if (valid) {
                const LAS f32x4* kr = (const LAS f32x4*)(Ks + j * 64);
                float s0 = 0.f, s1 = 0.f;
#pragma unroll
                for (int d4 = 0; d4 < 16; ++d4) { const f32x4 kv = kr[d4]; s0 += q[4 * d4] * kv[0] + q[4 * d4 + 2] * kv[2]; s1 += q[4 * d4 + 1] * kv[1] + q[4 * d4 + 3] * kv[3]; if ((d4 & 3) == 3) asm volatile("" ::: "memory"); }
                const float s = s0 + s1;
                if (s > mx) { const float a = fexp2(mx - s); l *= a;
#pragma unroll
                    for (int d = 0; d < 64; ++d) o[d] *= a;
                    mx = s; }
                const float p = fexp2(s - mx); l += p;
                const LAS f32x4* vr = (const LAS f32x4*)(Vs + j * 64);
#pragma unroll
                for (int d4 = 0; d4 < 16; ++d4) { const f32x4 vv = vr[d4]; o[4 * d4] += p * vv[0]; o[4 * d4 + 1] += p * vv[1]; o[4 * d4 + 2] += p * vv[2]; o[4 * d4 + 3] += p * vv[3]; if ((d4 & 3) == 3) asm volatile("" ::: "memory"); }
            }
        }
    }
    const float inv = 1.0f / l;
    bf16_t* op = YC + (size_t)(row0 + i) * DM + 512 + head * 64;
#pragma unroll
    for (int c8 = 0; c8 < 8; ++c8) { u32x4 w; w.x = pk2(o[8 * c8] * inv, o[8 * c8 + 1] * inv); w.y = pk2(o[8 * c8 + 2] * inv, o[8 * c8 + 3] * inv); w.z = pk2(o[8 * c8 + 4] * inv, o[8 * c8 + 5] * inv); w.w = pk2(o[8 * c8 + 6] * inv, o[8 * c8 + 7] * inv);
        *(u32x4*)(op + 8 * c8) = w; }
    __syncthreads();
}

__device__ __forceinline__ void ret_kv_unit(const bf16_t* PN, const bf16_t* VT, float* KV, const float* decay  , LAS unsigned char* lds, int b, int h, int c) {
    const int tid = tidx();
    LAS float* Ks = (LAS float*)lds; LAS float* Vs = (LAS float*)(lds + 32768); LAS f32x2* wt = (LAS f32x2*)(lds + 65536);
    const int row0 = chunk_row0(b, c);
    __syncthreads();
    stage_rows_f32(PN + (size_t)row0 * PN_LD + 256 + h * 64, PN_LD, Ks, tid);
    stage_cols_f32(VT + (size_t)(h * 64) * MTOT + row0, Vs, tid);
    if (tid < 128) { const float lg0 = decay[h], lg1 = decay[4 + h]; wt[tid] = (f32x2){fexp2(lg0 * (float)(127 - tid)), fexp2(lg1 * (float)tid)}; }
    __syncthreads();
    const int a = tid & 63, b0 = (tid >> 6) * 8;
    float acc0[8], acc1[8];
#pragma unroll
    for (int e = 0; e < 8; ++e) { acc0[e] = 0.f; acc1[e] = 0.f; }
#pragma unroll 4
    for (int p = 0; p < 128; ++p) {
        const float k = Ks[p * 64 + a]; const f32x2 w = wt[p]; const float k0 = k * w.x, k1 = k * w.y;
        const f32x4 va = *(const LAS f32x4*)(Vs + p * 64 + b0), vb = *(const LAS f32x4*)(Vs + p * 64 + b0 + 4);
        acc0[0] += k0 * va[0]; acc0[1] += k0 * va[1]; acc0[2] += k0 * va[2]; acc0[3] += k0 * va[3]; acc0[4] += k0 * vb[0]; acc0[5] += k0 * vb[1]; acc0[6] += k0 * vb[2]; acc0[7] += k0 * vb[3];
        acc1[0] += k1 * va[0]; acc1[1] += k1 * va[1]; acc1[2] += k1 * va[2]; acc1[3] += k1 * va[3]; acc1[4] += k1 * vb[0]; acc1[5] += k1 * vb[1]; acc1[6] += k1 * vb[2]; acc1[7] += k1 * vb[3];
    }
    float* o0 = KV + ((size_t)((0 * 2 + b) * 4 + h) * NCHUNK + c) * 4096 + a;
    float* o1 = KV + ((size_t)((1 * 2 + b) * 4 + h) * NCHUNK + c) * 4096 + a;
#pragma unroll
    for (int e = 0; e < 8; ++e) { o0[(b0 + e) * 64] = acc0[e]; o1[(b0 + e) * 64] = acc1[e]; }
}

__device__ __forceinline__ void ret_scan_unit(float* KV, const float* decay, int unit) {
    const int e = unit * 512 + tidx(), seq = e >> 12, idx = e & 4095, dir = seq >> 3, h = seq & 3;
    const float Gd = fexp2(decay[dir * 4 + h] * 128.0f);
    float* base = KV + (size_t)seq * NCHUNK * 4096 + idx;
    float v[NCHUNK];
#pragma unroll
    for (int st = 0; st < NCHUNK; ++st) { const int c = (dir == 0) ? (st < 2 ? 64 + st : st - 2) : 65 - st; v[st] = base[(size_t)c * 4096]; }
    float S = 0.f;
#pragma unroll
    for (int st = 0; st < NCHUNK; ++st) { const float kv = v[st]; v[st] = S; S = S * Gd + kv; }
#pragma unroll
    for (int st = 0; st < NCHUNK; ++st) { const int c = (dir == 0) ? (st < 2 ? 64 + st : st - 2) : 65 - st; base[(size_t)c * 4096] = v[st]; }
}

__device__ __forceinline__ void ret_out_unit(const bf16_t* PN, const bf16_t* VT, const float* KV, bf16_t* YC, const float* decay, const float* gnw  , LAS unsigned char* lds, int b, int h, int c) {
    const int tid = tidx(), p = tid & 127, dvq = tid >> 7;
    LAS float* Ks = (LAS float*)lds; LAS float* Vs = (LAS float*)(lds + 32768); LAS float* S0 = (LAS float*)(lds + 65536); LAS float* S1 = (LAS float*)(lds + 81920); LAS float* red = (LAS float*)(lds + 98304); LAS float* Qs = (LAS float*)(lds + 102400);
    const int row0 = chunk_row0(b, c);
    __syncthreads();
    stage_rows_f32(PN + (size_t)row0 * PN_LD + 256 + h * 64, PN_LD, Ks, tid);
    stage_cols_f32(VT + (size_t)(h * 64) * MTOT + row0, Vs, tid);
    { const float* s0 = KV + ((size_t)((0 * 2 + b) * 4 + h) * NCHUNK + c) * 4096 + tid * 8; const float* s1 = KV + ((size_t)((1 * 2 + b) * 4 + h) * NCHUNK + c) * 4096 + tid * 8;
      const f32x4 a0 = *(const f32x4*)s0, a1 = *(const f32x4*)(s0 + 4), b0 = *(const f32x4*)s1, b1 = *(const f32x4*)(s1 + 4);
      const int dv = tid >> 3, dk0 = (tid & 7) * 8;
#pragma unroll
      for (int e = 0; e < 4; ++e) { S0[(dk0 + e) * 64 + dv] = a0[e]; S0[(dk0 + 4 + e) * 64 + dv] = a1[e]; S1[(dk0 + e) * 64 + dv] = b0[e]; S1[(dk0 + 4 + e) * 64 + dv] = b1[e]; } }
    float q[64];
    { const bf16_t* qp = PN + (size_t)(row0 + p) * PN_LD + h * 64;
#pragma unroll
      for (int c8 = 0; c8 < 8; ++c8) { const u32x4 a = *(const u32x4*)(qp + 8 * c8);
          q[8 * c8] = bf_lo(a.x); q[8 * c8 + 1] = bf_hi(a.x); q[8 * c8 + 2] = bf_lo(a.y); q[8 * c8 + 3] = bf_hi(a.y); q[8 * c8 + 4] = bf_lo(a.z); q[8 * c8 + 5] = bf_hi(a.z); q[8 * c8 + 6] = bf_lo(a.w); q[8 * c8 + 7] = bf_hi(a.w); } }
    if (dvq == 0) {
#pragma unroll
        for (int d = 0; d < 64; ++d) Qs[p * 65 + d] = q[d]; }
    const float lg0 = decay[h], lg1 = decay[4 + h];
    __syncthreads();
    float out[16];
#pragma unroll
    for (int v = 0; v < 16; ++v) out[v] = 0.f;
    for (int pp = 0; pp < 128; ++pp) {
        const LAS f32x4* kr = (const LAS f32x4*)(Ks + pp * 64);
        float s0 = 0.f, s1 = 0.f;
#pragma unroll
        for (int d4 = 0; d4 < 16; ++d4) { const f32x4 kv = kr[d4]; s0 += q[4 * d4] * kv[0] + q[4 * d4 + 2] * kv[2]; s1 += q[4 * d4 + 1] * kv[1] + q[4 * d4 + 3] * kv[3]; if ((d4 & 3) == 3) asm volatile("" ::: "memory"); }
        const float df = (float)(p - pp);
        const float dec = df > 0.f ? fexp2(lg0 * df) : (df < 0.f ? fexp2(-lg1 * df) : 2.0f);
        const float s = (s0 + s1) * dec;
        const LAS f32x4* vr = (const LAS f32x4*)(Vs + pp * 64 + dvq * 16);
#pragma unroll
        for (int v4 = 0; v4 < 4; ++v4) { const f32x4 vv = vr[v4]; out[4 * v4] += s * vv[0]; out[4 * v4 + 1] += s * vv[1]; out[4 * v4 + 2] += s * vv[2]; out[4 * v4 + 3] += s * vv[3]; }
    }
    {
        float x0[16], x1[16];
#pragma unroll
        for (int v = 0; v < 16; ++v) { x0[v] = 0.f; x1[v] = 0.f; }
#pragma unroll 2
        for (int dk = 0; dk < 64; ++dk) {
            const float t = Qs[p * 65 + dk];
            const LAS f32x4* r0 = (const LAS f32x4*)(S0 + dk * 64 + dvq * 16); const LAS f32x4* r1 = (const LAS f32x4*)(S1 + dk * 64 + dvq * 16);
#pragma unroll
            for (int v4 = 0; v4 < 4; ++v4) { const f32x4 a = r0[v4], bb = r1[v4];
                x0[4 * v4] += t * a[0]; x0[4 * v4 + 1] += t * a[1]; x0[4 * v4 + 2] += t * a[2]; x0[4 * v4 + 3] += t * a[3];
                x1[4 * v4] += t * bb[0]; x1[4 * v4 + 1] += t * bb[1]; x1[4 * v4 + 2] += t * bb[2]; x1[4 * v4 + 3] += t * bb[3]; }
        }
        const float f0 = fexp2(lg0 * (float)(p + 1)), f1 = fexp2(lg1 * (float)(128 - p));
#pragma unroll
        for (int v = 0; v < 16; ++v) out[v] += x0[v] * f0 + x1[v] * f1;
    }
    float s = 0.f;
#pragma unroll
    for (int v = 0; v < 16; ++v) s += out[v];
    red[dvq * 128 + p] = s;
    __syncthreads();
    const float mu = (red[p] + red[128 + p] + red[256 + p] + red[384 + p]) * (1.0f / 64.0f);
    float qv = 0.f;
#pragma unroll
    for (int v = 0; v < 16; ++v) { const float d = out[v] - mu; qv += d * d; }
    red[512 + dvq * 128 + p] = qv;
    __syncthreads();
    const float var = (red[512 + p] + red[640 + p] + red[768 + p] + red[896 + p]) * (1.0f / 64.0f);
    const float rstd = 1.0f / sqrtf(var + NORM_EPS);
    const bf16_t* gp = PN + (size_t)(row0 + p) * PN_LD + 512 + h * 64 + dvq * 16;
    const u32x4 ga = *(const u32x4*)gp, gb = *(const u32x4*)(gp + 8);
    float gt[16] = {bf_lo(ga.x), bf_hi(ga.x), bf_lo(ga.y), bf_hi(ga.y), bf_lo(ga.z), bf_hi(ga.z), bf_lo(ga.w), bf_hi(ga.w), bf_lo(gb.x), bf_hi(gb.x), bf_lo(gb.y), bf_hi(gb.y), bf_lo(gb.z), bf_hi(gb.z), bf_lo(gb.w), bf_hi(gb.w)};
    float y[16];
#pragma unroll
    for (int v = 0; v < 16; ++v) y[v] = silu_f(gt[v]) * ((out[v] - mu) * rstd * gnw[h * 64 + dvq * 16 + v]);
    bf16_t* op = YC + (size_t)(row0 + p) * DM + 256 + h * 64 + dvq * 16;
    u32x4 w0, w1;
    w0.x = pk2(y[0], y[1]); w0.y = pk2(y[2], y[3]); w0.z = pk2(y[4], y[5]); w0.w = pk2(y[6], y[7]);
    w1.x = pk2(y[8], y[9]); w1.y = pk2(y[10], y[11]); w1.z = pk2(y[12], y[13]); w1.w = pk2(y[14], y[15]);
    *(u32x4*)op = w0; *(u32x4*)(op + 8) = w1;
}

__device__ __forceinline__ f32x2 cmul(f32x2 a, f32x2 w) { return (f32x2){a.x * w.x - a.y * w.y, a.x * w.y + a.y * w.x}; }
__device__ __forceinline__ void fft_unit(const float* GT, bf16_t* YC, LAS unsigned char* lds, int b, int g, int m, bool isctx, int pflags = 0) {
    const int tid = tidx();
    const int logL = isctx ? 8 : 13, Lf = 1 << logL, tok0 = isctx ? MLAT + b * CTXL : b * SEQ;
    LAS f32x2* X = (LAS f32x2*)lds; const LAS f32x2* tw = (const LAS f32x2*)(lds + 73728);
    const float* gr = GT + (size_t)(g * 128 + m) * MTOT + tok0; const float* gi = (m == 0) ? gr + (size_t)32 * MTOT : gr + (size_t)64 * MTOT;
    __syncthreads();
    for (int i = tid; i < Lf; i += 512) X[i] = (f32x2){gr[i], gi[i]};
    __syncthreads();
    int s = 0;
    for (; s + 1 < logL; s += 2) {
        const int qb = logL - 2 - s, quarter = 1 << qb;
        const LAS f32x2* tw1 = tw + (8192 - (8192 >> (s + 13 - logL)));
        const LAS f32x2* tw2 = tw + (8192 - (8192 >> (s + 14 - logL)));
        for (int t = tid; t < (Lf >> 2); t += 512) {
            const int j = t & (quarter - 1), i0 = ((t >> qb) << (qb + 2)) + j;
            const f32x2 a = X[i0], bq = X[i0 + quarter], c = X[i0 + 2 * quarter], d = X[i0 + 3 * quarter];
            const f32x2 w1 = tw1[j], w2 = tw2[j];
            const f32x2 t0 = {a.x + c.x, a.y + c.y}, t1 = {a.x - c.x, a.y - c.y}, t2 = {bq.x + d.x, bq.y + d.y};
            const f32x2 t3 = {bq.y - d.y, d.x - bq.x};
            const f32x2 w3 = cmul(w1, w2);
            X[i0] = (f32x2){t0.x + t2.x, t0.y + t2.y};
            X[i0 + quarter] = cmul((f32x2){t0.x - t2.x, t0.y - t2.y}, w2);
            X[i0 + 2 * quarter] = cmul((f32x2){t1.x + t3.x, t1.y + t3.y}, w1);
            X[i0 + 3 * quarter] = cmul((f32x2){t1.x - t3.x, t1.y - t3.y}, w3);
        }
        __syncthreads();
    }
    if (s < logL) {
        for (int t = tid; t < (Lf >> 1); t += 512) { const f32x2 a = X[2 * t], bb = X[2 * t + 1]; X[2 * t] = (f32x2){a.x + bb.x, a.y + bb.y}; X[2 * t + 1] = (f32x2){a.x - bb.x, a.y - bb.y}; }
        __syncthreads();
    }
    const float scale = 1.0f / sqrtf((float)Lf * 64.0f);
    if (pflags & 2) return;
    unsigned* yo = (unsigned*)(YC + (size_t)tok0 * DM + g * 64 + 2 * m);
    const int sh = 32 - logL;
    if (m != 0) {
        for (int k = tid; k < Lf; k += 512) { const int i1 = (int)(__brev((unsigned)k) >> sh), i2 = (int)(__brev((unsigned)((Lf - k) & (Lf - 1))) >> sh);
            yo[(size_t)k * (DM / 2)] = pk2(X[i1].x * scale, X[i2].x * scale); }
    } else {
        const float hs = 0.5f * scale;
        for (int k = tid; k < Lf; k += 512) { const int i1 = (int)(__brev((unsigned)k) >> sh), i2 = (int)(__brev((unsigned)((Lf - k) & (Lf - 1))) >> sh);
            const f32x2 z = X[i1], zp = X[i2]; yo[(size_t)k * (DM / 2)] = pk2((z.x + zp.x) * hs, (z.y + zp.y) * hs); }
    }
}

typedef short bf16x8 __attribute__((ext_vector_type(8)));
typedef float f32x16 __attribute__((ext_vector_type(16)));
typedef __bf16 bf16x2_t __attribute__((ext_vector_type(2)));
#define MFMA32(a, b, c) __builtin_amdgcn_mfma_f32_32x32x16_bf16((a), (b), (c), 0, 0, 0)
__device__ __forceinline__ unsigned cvtpk(float lo, float hi) { f32x2 v = {lo, hi}; bf16x2_t b = __builtin_convertvector(v, bf16x2_t); return __builtin_bit_cast(unsigned, b); }
template <int S> __device__ __forceinline__ bf16x8 pack8(const f32x16& x) {
    u32x4 p; p.x = cvtpk(x[8 * S], x[8 * S + 1]); p.y = cvtpk(x[8 * S + 2], x[8 * S + 3]); p.z = cvtpk(x[8 * S + 4], x[8 * S + 5]); p.w = cvtpk(x[8 * S + 6], x[8 * S + 7]);
    return __builtin_bit_cast(bf16x8, p);
}
__device__ __forceinline__ f32x16 zero16() { f32x16 z; float zz = 0.f; asm volatile("" : "+v"(zz));
#pragma unroll
    for (int i = 0; i < 16; ++i) z[i] = zz;
    return z; }
__device__ __forceinline__ void ldg_rows(const bf16_t* src, int ld, int tid, u32x4& a, u32x4& b) { const bf16_t* p = src + (size_t)(tid >> 2) * ld + (tid & 3) * 16; a = *(const u32x4*)p; b = *(const u32x4*)(p + 8); }
__device__ __forceinline__ void sts_rows(LAS unsigned char* dst, int tid, const u32x4& a, const u32x4& b) { LAS u32x4* o = (LAS u32x4*)(dst + (tid >> 2) * 144 + (tid & 3) * 32); o[0] = a; o[1] = b; }
__device__ __forceinline__ void ldg_cols(const bf16_t* src, int tid, u32x4& a, u32x4& b) { const bf16_t* p = src + (size_t)(tid >> 3) * MTOT + (tid & 7) * 16; a = *(const u32x4*)p; b = *(const u32x4*)(p + 8); }
__device__ __forceinline__ void sts_cols(LAS unsigned char* dst, int tid, const u32x4& a, const u32x4& b) { LAS u32x2* o = (LAS u32x2*)(dst + (tid >> 3) * 264 + (tid & 7) * 32);
    o[0] = (u32x2){a.x, a.y}; o[1] = (u32x2){a.z, a.w}; o[2] = (u32x2){b.x, b.y}; o[3] = (u32x2){b.z, b.w}; }
__device__ __forceinline__ bf16x8 vt_frag(const LAS unsigned char* Vt, int frow, int k0, int hi) {
    const LAS unsigned char* vp = Vt + frow * 264 + (k0 + 4 * hi) * 2; const u32x2 lo = *(const LAS u32x2*)vp, hh = *(const LAS u32x2*)(vp + 16);
    return __builtin_bit_cast(bf16x8, (u32x4){lo.x, lo.y, hh.x, hh.y});
}

__device__ __forceinline__ void attn_unit_mfma(const bf16_t* PN, const bf16_t* VT, bf16_t* YC, const float* sink, LAS unsigned char* lds, int b, int kvh, int qt, bool isctx) {
    const int tid = tidx(), lane = tid & 63, wid = __builtin_amdgcn_readfirstlane(tid >> 6), q32 = lane & 31, hi = lane >> 5;
    const int g = wid >> 1, qh = wid & 1, head = kvh * 4 + g;
    const int row0 = isctx ? MLAT + b * CTXL + 128 * qt : b * SEQ + 128 * qt;
    LAS unsigned char* Ks = lds; LAS unsigned char* Vt = lds + 18432;
    LAS unsigned char* Qf = lds + 36864 + wid * 8192 + lane * 16;
    __syncthreads();
#pragma unroll
    for (int qs = 0; qs < 2; ++qs)
#pragma unroll
        for (int ks = 0; ks < 4; ++ks) *(LAS bf16x8*)(Qf + (qs * 4 + ks) * 1024) = *(const bf16x8*)(PN + (size_t)(row0 + 64 * qh + 32 * qs + q32) * PN_LD + 768 + head * 64 + 16 * ks + 8 * hi);
    f32x16 o[2][2];
#pragma unroll
    for (int qs = 0; qs < 2; ++qs) { o[qs][0] = zero16(); o[qs][1] = zero16(); }
    const float sk = sink[head] * LOG2E;
    float mx[2] = {sk, sk}; float l[2] = {hi ? 0.f : 1.f, hi ? 0.f : 1.f};
    unsigned mask = isctx ? 0x18u : (0x1Au | (qt > 0 ? 1u : 0u) | (qt < 63 ? 4u : 0u));
    int ch = __builtin_ctz(mask);
    u32x4 ka, kb, va, vb;
    { const int krow0 = ch < 3 ? b * SEQ + 128 * (qt - 1 + ch) : MLAT + b * CTXL + 128 * (ch - 3);
      ldg_rows(PN + (size_t)krow0 * PN_LD + 1280 + kvh * 64, PN_LD, tid, ka, kb); ldg_cols(VT + (size_t)(256 + kvh * 64) * MTOT + krow0, tid, va, vb); }
    for (;;) {
        __syncthreads();
        sts_rows(Ks, tid, ka, kb); sts_cols(Vt, tid, va, vb);
        __syncthreads();
        mask &= mask - 1u;
        const int cur = ch;
        if (mask) { ch = __builtin_ctz(mask); const int krow0 = ch < 3 ? b * SEQ + 128 * (qt - 1 + ch) : MLAT + b * CTXL + 128 * (ch - 3);
            const int t2 = tidx();
            ldg_rows(PN + (size_t)krow0 * PN_LD + 1280 + kvh * 64, PN_LD, t2, ka, kb); ldg_cols(VT + (size_t)(256 + kvh * 64) * MTOT + krow0, t2, va, vb); }
        const float sgnbig = (cur == 0) ? 1e30f : -1e30f;
#pragma unroll
        for (int kt = 0; kt < 4; ++kt) {
            asm volatile("" ::: "memory");
            f32x16 s[2]; s[0] = zero16(); s[1] = zero16();
#pragma unroll
            for (int ks = 0; ks < 4; ++ks) { const bf16x8 a = *(const LAS bf16x8*)(Ks + (kt * 32 + q32) * 144 + ks * 32 + hi * 16);
                s[0] = MFMA32(a, *(const LAS bf16x8*)(Qf + (0 * 4 + ks) * 1024), s[0]); s[1] = MFMA32(a, *(const LAS bf16x8*)(Qf + (1 * 4 + ks) * 1024), s[1]); }
            bf16x8 pk[2][2];
#pragma unroll
            for (int qs = 0; qs < 2; ++qs) {
                if (cur == 0 || cur == 2) {
                    float thr = (float)(64 * qh + 32 * qs + q32 - 4 * hi); asm volatile("" : "+v"(thr));
#pragma unroll
                    for (int r = 0; r < 16; ++r) { const float jc = (float)(kt * 32 + (r & 3) + 8 * (r >> 2)); s[qs][r] += fminf(0.f, (jc - thr) * sgnbig); } }
                float mloc = fmaxf(fmaxf(s[qs][0], s[qs][1]), fmaxf(s[qs][2], s[qs][3]));
#pragma unroll
                for (int r = 4; r < 16; r += 4) mloc = fmaxf(mloc, fmaxf(fmaxf(s[qs][r], s[qs][r + 1]), fmaxf(s[qs][r + 2], s[qs][r + 3])));
                mloc = fmaxf(mloc, __shfl_xor(mloc, 32));
                const float mnew = fmaxf(mx[qs], mloc), alpha = fexp2(mx[qs] - mnew); mx[qs] = mnew;
                float ls = 0.f;
#pragma unroll
                for (int r = 0; r < 16; ++r) { const float p = fexp2(s[qs][r] - mnew); s[qs][r] = p; ls += p; }
                l[qs] = l[qs] * alpha + ls;
                if (__builtin_amdgcn_ballot_w64(alpha != 1.0f)) { o[qs][0] = o[qs][0] * alpha; o[qs][1] = o[qs][1] * alpha; }
                pk[qs][0] = pack8<0>(s[qs]); pk[qs][1] = pack8<1>(s[qs]);
            }
#pragma unroll
            for (int dt = 0; dt < 2; ++dt) {
                const bf16x8 va = vt_frag(Vt, dt * 32 + q32, kt * 32, hi), vb = vt_frag(Vt, dt * 32 + q32, kt * 32 + 16, hi);
                o[0][dt] = MFMA32(va, pk[0][0], o[0][dt]); o[1][dt] = MFMA32(va, pk[1][0], o[1][dt]);
                o[0][dt] = MFMA32(vb, pk[0][1], o[0][dt]); o[1][dt] = MFMA32(vb, pk[1][1], o[1][dt]); }
        }
        if (!mask) break;
    }
    const int t3 = tidx(), q32b = t3 & 31, hib = (t3 >> 5) & 1;
#pragma unroll
    for (int qs = 0; qs < 2; ++qs) {
        const float lt = l[qs] + __shfl_xor(l[qs], 32), inv = 1.0f / lt;
        bf16_t* op = YC + (size_t)(row0 + 64 * qh + 32 * qs + q32b) * DM + 512 + head * 64;
#pragma unroll
        for (int dt = 0; dt < 2; ++dt)
#pragma unroll
            for (int rg = 0; rg < 4; ++rg) { u32x2 w; w.x = cvtpk(o[qs][dt][4 * rg] * inv, o[qs][dt][4 * rg + 1] * inv); w.y = cvtpk(o[qs][dt][4 * rg + 2] * inv, o[qs][dt][4 * rg + 3] * inv);
                *(u32x2*)(op + dt * 32 + 8 * rg + 4 * hib) = w; }
    }
}

__device__ __forceinline__ void ret_out_unit_mfma(const bf16_t* PN, const bf16_t* VT, const float* KV, bf16_t* YC, const float* decay, const float* gnw, LAS unsigned char* lds, int b, int h, int c) {
    const int tid = tidx(), lane = tid & 63, wid = __builtin_amdgcn_readfirstlane(tid >> 6), q32 = lane & 31, hi = lane >> 5;
    const int pt = wid >> 1, dt = wid & 1;
    LAS unsigned char* Ks = lds; LAS unsigned char* Vt = lds + 18432; LAS unsigned char* S0t = lds + 35328; LAS unsigned char* S1t = lds + 44544; LAS float* Out = (LAS float*)(lds + 53760);
    const int row0 = chunk_row0(b, c);
    __syncthreads();
    { u32x4 ka, kb, va, vb; ldg_rows(PN + (size_t)row0 * PN_LD + 256 + h * 64, PN_LD, tid, ka, kb); ldg_cols(VT + (size_t)(h * 64) * MTOT + row0, tid, va, vb);
      const float* s0 = KV + ((size_t)((0 * 2 + b) * 4 + h) * NCHUNK + c) * 4096 + tid * 8; const float* s1 = KV + ((size_t)((1 * 2 + b) * 4 + h) * NCHUNK + c) * 4096 + tid * 8;
      const f32x4 a0 = *(const f32x4*)s0, a1 = *(const f32x4*)(s0 + 4), b0 = *(const f32x4*)s1, b1 = *(const f32x4*)(s1 + 4);
      sts_rows(Ks, tid, ka, kb); sts_cols(Vt, tid, va, vb);
      const int dv = tid >> 3, dk0 = (tid & 7) * 8;
      *(LAS u32x4*)(S0t + dv * 144 + dk0 * 2) = (u32x4){cvtpk(a0[0], a0[1]), cvtpk(a0[2], a0[3]), cvtpk(a1[0], a1[1]), cvtpk(a1[2], a1[3])};
      *(LAS u32x4*)(S1t + dv * 144 + dk0 * 2) = (u32x4){cvtpk(b0[0], b0[1]), cvtpk(b0[2], b0[3]), cvtpk(b1[0], b1[1]), cvtpk(b1[2], b1[3])}; }
    bf16x8 qf[4];
#pragma unroll
    for (int ks = 0; ks < 4; ++ks) qf[ks] = *(const bf16x8*)(PN + (size_t)(row0 + 32 * pt + q32) * PN_LD + h * 64 + 16 * ks + 8 * hi);
    const float lg0 = decay[h], lg1 = decay[4 + h];
    __syncthreads();
    const int p = 32 * pt + q32;
    f32x16 o = zero16();
#pragma unroll
    for (int kt = 0; kt < 4; ++kt) {
        f32x16 s = zero16();
#pragma unroll
        for (int ks = 0; ks < 4; ++ks) { const bf16x8 a = *(const LAS bf16x8*)(Ks + (kt * 32 + q32) * 144 + ks * 32 + hi * 16); s = MFMA32(a, qf[ks], s); }
#pragma unroll
        for (int r = 0; r < 16; ++r) { const int pp = kt * 32 + (r & 3) + 8 * (r >> 2) + 4 * hi; const float df = (float)(p - pp);
            const float ex = fexp2((df > 0.f ? lg0 : -lg1) * df); const float dec = (df == 0.f) ? 2.0f : ex; s[r] *= dec; }
        o = MFMA32(vt_frag(Vt, dt * 32 + q32, kt * 32, hi), pack8<0>(s), o);
        o = MFMA32(vt_frag(Vt, dt * 32 + q32, kt * 32 + 16, hi), pack8<1>(s), o);
    }
    {   f32x16 x0 = zero16(), x1 = zero16();
#pragma unroll
        for (int ks = 0; ks < 4; ++ks) { const bf16x8 a0 = *(const LAS bf16x8*)(S0t + (dt * 32 + q32) * 144 + ks * 32 + hi * 16), a1 = *(const LAS bf16x8*)(S1t + (dt * 32 + q32) * 144 + ks * 32 + hi * 16);
            x0 = MFMA32(a0, qf[ks], x0); x1 = MFMA32(a1, qf[ks], x1); }
        const float f0 = fexp2(lg0 * (float)(p + 1)), f1 = fexp2(lg1 * (float)(128 - p));
        o = o + x0 * f0 + x1 * f1; }
#pragma unroll
    for (int rg = 0; rg < 4; ++rg) *(LAS f32x4*)(Out + p * 68 + dt * 32 + 8 * rg + 4 * hi) = (f32x4){o[4 * rg], o[4 * rg + 1], o[4 * rg + 2], o[4 * rg + 3]};
    __syncthreads();
    const int p2 = tid >> 2, dvq = tid & 3;
    float out[16];
#pragma unroll
    for (int v4 = 0; v4 < 4; ++v4) { const f32x4 t = *(const LAS f32x4*)(Out + p2 * 68 + dvq * 16 + 4 * v4); out[4 * v4] = t[0]; out[4 * v4 + 1] = t[1]; out[4 * v4 + 2] = t[2]; out[4 * v4 + 3] = t[3]; }
    float sm = 0.f;
#pragma unroll
    for (int v = 0; v < 16; ++v) sm += out[v];
    sm += __shfl_xor(sm, 1); sm += __shfl_xor(sm, 2);
    const float mu = sm * (1.0f / 64.0f);
    float qv = 0.f;
#pragma unroll
    for (int v = 0; v < 16; ++v) { const float d = out[v] - mu; qv += d * d; }
    qv += __shfl_xor(qv, 1); qv += __shfl_xor(qv, 2);
    const float rstd = 1.0f / sqrtf(qv * (1.0f / 64.0f) + NORM_EPS);
    const bf16_t* gp = PN + (size_t)(row0 + p2) * PN_LD + 512 + h * 64 + dvq * 16;
    const u32x4 ga = *(const u32x4*)gp, gb = *(const u32x4*)(gp + 8);
    const float gt[16] = {bf_lo(ga.x), bf_hi(ga.x), bf_lo(ga.y), bf_hi(ga.y), bf_lo(ga.z), bf_hi(ga.z), bf_lo(ga.w), bf_hi(ga.w), bf_lo(gb.x), bf_hi(gb.x), bf_lo(gb.y), bf_hi(gb.y), bf_lo(gb.z), bf_hi(gb.z), bf_lo(gb.w), bf_hi(gb.w)};
    float y[16];
#pragma unroll
    for (int v = 0; v < 16; ++v) y[v] = silu_f(gt[v]) * ((out[v] - mu) * rstd * gnw[h * 64 + dvq * 16 + v]);
    bf16_t* op = YC + (size_t)(row0 + p2) * DM + 256 + h * 64 + dvq * 16;
    u32x4 w0, w1;
    w0.x = cvtpk(y[0], y[1]); w0.y = cvtpk(y[2], y[3]); w0.z = cvtpk(y[4], y[5]); w0.w = cvtpk(y[6], y[7]);
    w1.x = cvtpk(y[8], y[9]); w1.y = cvtpk(y[10], y[11]); w1.z = cvtpk(y[12], y[13]); w1.w = cvtpk(y[14], y[15]);
    *(u32x4*)op = w0; *(u32x4*)(op + 8) = w1;
}

__device__ __forceinline__ void ret_kv_unit_mfma(const bf16_t* PN, const bf16_t* VT, float* KV, const float* decay, LAS unsigned char* lds, int b, int h, int c) {
    const int tid = tidx(), lane = tid & 63, wid = __builtin_amdgcn_readfirstlane(tid >> 6), q32 = lane & 31, hi = lane >> 5;
    const int dir = wid >> 2, dt = (wid >> 1) & 1, nt = wid & 1;
    LAS unsigned char* Ks = lds; LAS unsigned char* Vt = lds + 18432; LAS f32x2* wt = (LAS f32x2*)(lds + 35328);
    const int row0 = chunk_row0(b, c);
    __syncthreads();
    { u32x4 ka, kb, va, vb; ldg_rows(PN + (size_t)row0 * PN_LD + 256 + h * 64, PN_LD, tid, ka, kb); ldg_cols(VT + (size_t)(h * 64) * MTOT + row0, tid, va, vb);
      sts_rows(Ks, tid, ka, kb); sts_cols(Vt, tid, va, vb);
      if (tid < 128) wt[tid] = (f32x2){fexp2(decay[h] * (float)(127 - tid)), fexp2(decay[4 + h] * (float)tid)}; }
    __syncthreads();
    f32x16 acc = zero16();
#pragma unroll
    for (int ks = 0; ks < 8; ++ks) {
        const LAS unsigned char* vp = Vt + (32 * dt + q32) * 264 + (16 * ks + 8 * hi) * 2;
        const u32x2 lo = *(const LAS u32x2*)vp, hh = *(const LAS u32x2*)(vp + 8);
        const bf16x8 a = __builtin_bit_cast(bf16x8, (u32x4){lo.x, lo.y, hh.x, hh.y});
        float kw[8];
#pragma unroll
        for (int e = 0; e < 8; ++e) { const int p = 16 * ks + 8 * hi + e; const unsigned kv = *(const LAS unsigned short*)(Ks + p * 144 + (32 * nt + q32) * 2);
            const f32x2 w = wt[p]; kw[e] = __builtin_bit_cast(float, kv << 16) * (dir ? w.y : w.x); }
        const bf16x8 bq = __builtin_bit_cast(bf16x8, (u32x4){cvtpk(kw[0], kw[1]), cvtpk(kw[2], kw[3]), cvtpk(kw[4], kw[5]), cvtpk(kw[6], kw[7])});
        acc = MFMA32(a, bq, acc);
    }
    float* o = KV + ((size_t)((dir * 2 + b) * 4 + h) * NCHUNK + c) * 4096 + 32 * nt + q32;
#pragma unroll
    for (int r = 0; r < 16; ++r) o[(32 * dt + (r & 3) + 8 * (r >> 2) + 4 * hi) * 64] = acc[r];
}

typedef __attribute__((address_space(4))) const Params* KParams;
__device__ __forceinline__ KParams kparams() { KParams p = (KParams)__builtin_amdgcn_kernarg_segment_ptr(); asm volatile("" : "+s"(p)); return p; }
struct UniEpi {
    static constexpr bool PERM = false, AFTER_DRAIN = false;
    int mode;
    int L;
    int midx;
    LAS unsigned char* xl;
    __device__ __forceinline__ void operator()(const f32x4 (&acc)[2][2][4][2], const Unit& u, int wr, int wc, int fr, int fq) const {
        KParams K = kparams(); unsigned char* ws = K->ws;
        if (mode == 3 || mode == 4) return;
        if (mode == 0) { EpiSwiglu E{(bf16_t*)(ws + OFF_ACT)}; E(acc, u, wr, wc, fr, fq); }
        else if (mode == 1) { const bool first = (midx & 256) != 0; const int mi = midx & 255; float* HC = (float*)(ws + OFF_HC);
            EpiResid E{first ? K->x : K->out, first ? K->ctx : HC, K->out, HC, (const float*)(ws + OFF_MOD) + (size_t)(L * 27 + mi) * DM, mi == 5 ? 1.0f : 0.5f}; E(acc, u, wr, wc, fr, fq); }
        else { EpiInProj E{(bf16_t*)(ws + OFF_PN), (float*)(ws + OFF_GT), (bf16_t*)(ws + OFF_VT), (const float*)(ws + OFF_ROPE), 66 + 10 * L, 72 + 10 * L}; E(acc, u, wr, wc, fr, fq); }
    }
    __device__ __forceinline__ void tail(f32x4 (&acc)[2][2][4][2], const Unit& u, int wr, int wc, int fr, int fq) const {
        if (mode != 4) return;
        KParams K = kparams(); unsigned char* ws = K->ws;
        { const bool first = (midx & 256) != 0; const int mi = midx & 255; float* HC = (float*)(ws + OFF_HC);
            const int kk = mi == 2 ? 0 : (mi == 5 ? 1 : 2), nL = (kk == 2 && L == 0) ? 1 : L, widx = (kk == 0) ? 1 : (kk == 1 ? 2 : 0), ni = (kk == 0) ? 3 : (kk == 1 ? 6 : 0);
            const float* modN = (const float*)(ws + OFF_MOD) + (size_t)nL * 27 * DM;
            epi_resid_norm(acc, u, wr, wc, fr, fq, first ? K->x : K->out, first ? K->ctx : HC, K->out, HC, (const float*)(ws + OFF_MOD) + (size_t)(L * 27 + mi) * DM, mi == 5 ? 1.0f : 0.5f,
                           K->norm_w + (size_t)(nL * 3 + widx) * DM, modN + (size_t)ni * DM, modN + (size_t)(ni + 1) * DM, (bf16_t*)(ws + OFF_R),
                           (float*)(ws + OFF_XBUF) + (size_t)(L * 3 + kk) * MTOT * 4, (unsigned*)(ws + OFF_BAR + 65536) + (size_t)((L * 3 + kk) * 66) * 64, xl, (L == 1 && kk == 2) ? K->final_norm_w : nullptr); }
    }
};
__device__ __forceinline__ void gate_signal(unsigned* cnt) {
    asm volatile("s_waitcnt vmcnt(0)" ::: "memory");
    __builtin_amdgcn_fence(__ATOMIC_RELEASE, "agent");
    asm volatile("s_waitcnt vmcnt(0)" ::: "memory");
    if ((tidx() & 63) == 0) __hip_atomic_fetch_add(cnt, 1u, __ATOMIC_RELAXED, __HIP_MEMORY_SCOPE_AGENT);
}
__device__ __forceinline__ void gate_wait(unsigned* cnt, unsigned need) {
    if (tidx() < 64) { unsigned sp = 0;
        while ((unsigned)__builtin_amdgcn_readfirstlane(__hip_atomic_load(cnt, __ATOMIC_RELAXED, __HIP_MEMORY_SCOPE_AGENT)) < need) { __builtin_amdgcn_s_sleep(2); if (++sp > (1u << 22)) break; }
        __builtin_amdgcn_fence(__ATOMIC_ACQUIRE, "agent"); asm volatile("s_waitcnt vmcnt(0)" ::: "memory"); }
    __syncthreads();
}
__device__ __forceinline__ void wg_signal(unsigned* cnt) {
    asm volatile("s_waitcnt vmcnt(0)" ::: "memory"); __syncthreads();
    if (tidx() == 0) { __builtin_amdgcn_fence(__ATOMIC_RELEASE, "agent"); asm volatile("s_waitcnt vmcnt(0)" ::: "memory"); __hip_atomic_fetch_add(cnt, 1u, __ATOMIC_RELAXED, __HIP_MEMORY_SCOPE_AGENT); }
}
constexpr int NDED = 8, NWORK = 256 - NDED;
struct UniSched {
    int mode; pg8::StaticOrder so; int L; unsigned* cnt;
    __device__ __forceinline__ bool next(int i, Unit& u) const {
        if (mode == 0) return so.next(i, u);
        if (mode == 1) { InSched is{so.G, so.c, 66 + 10 * L, 72 + 10 * L}; return is.next(i, u); }
        if (mode == 2) { if (so.c >= NWORK) return false; const int lin = i * NWORK + so.c;
            if (lin < 44) { u.pm = 64 + lin / 22; u.pn = lin % 22; return true; }
            if (lin - 44 >= 64 * 22) return false;
            pg8::StaticOrder t = so; t.G = 0; t.c = lin - 44; return t.next(0, u); }
        if (i > 0 || so.c < NWORK) return false;
        u.pm = 64 + ((so.c - NWORK) >> 2); u.pn = (so.c - NWORK) & 3; return true;
    }
    __device__ __forceinline__ void a_ready(const Unit&) const {}
    __device__ __forceinline__ void done(const Unit& u) const { if (mode == 2 && cnt != nullptr && u.pm >= 64) gate_signal(cnt); }
};


#ifdef ATT_VALU
#define ATTN_FN attn_unit
#else
#define ATTN_FN attn_unit_mfma
#endif
#ifdef KV_VALU
#define KV_FN ret_kv_unit
#else
#define KV_FN ret_kv_unit_mfma
#endif
#ifdef RO_VALU
#define RO_FN ret_out_unit
#else
#define RO_FN ret_out_unit_mfma
#endif

constexpr int LDS_ST_OFF = LDS_BYTES - 16;
__device__ __forceinline__ void grid_barrier(LAS unsigned char* lds) {
#ifdef USE_CG_SYNC
    cg::this_grid().sync();
#else
    XcdBarrier b; b.bar = (unsigned*)(kparams()->ws + OFF_BAR); b.x = xb_xcc_id(); b.st = (volatile LAS unsigned*)(lds + LDS_ST_OFF);
    xcd_barrier(b);
#endif
}
#ifndef FUSE_NORM
#define FUSE_NORM 1
#endif
#ifndef MERGE_MIX
#define MERGE_MIX 0
#endif
#ifndef FUSE2
#define FUSE2 1
#endif
#ifndef FUSE_FINAL
#define FUSE_FINAL 0
#endif
__global__ void __launch_bounds__(512) fwd_megakernel(Params Pin) {
    extern __shared__ __attribute__((aligned(16))) unsigned char lds_raw[];
    LAS unsigned char* lds = (LAS unsigned char*)lds_raw;
#ifndef USE_CG_SYNC
    if (tidx() < 4) ((LAS unsigned*)(lds + LDS_ST_OFF))[tidx()] = 0u;
    __syncthreads();
    (void)xcd_barrier_post((unsigned*)(kparams()->ws + OFF_BAR), (volatile LAS unsigned*)(lds + LDS_ST_OFF));
    if (kparams()->ws == nullptr) cg::this_grid().sync();
#endif
#ifdef PROBE_REP
#define NREP(t) ((((PROBE_REP) >> (t)) & 1) ? 2 : 1)
#define XSYNC() do { if (((PROBE_REP) >> 9) & 1) grid_barrier(lds); } while (0)
#else
#define NREP(t) 1
#define XSYNC() do {} while (0)
#endif
    for (int rep = 0; rep < NREP(0); ++rep) {
#ifndef NO_P0
        p0_prologue(*kparams(), lds);
#endif
    }
    grid_barrier(lds); XSYNC();
    for (int L = 0; L < 2; ++L)
    for (int r = 0; r < 12; ++r) {
        const int ptype = (r == 0 || r == 3 || r == 9) ? 1 : ((r == 1 || r == 10) ? 2 : ((r == 2 || r == 11) ? 3 : r));
        const int nrep = NREP(ptype);
      for (int rep = 0; rep < nrep; ++rep) {
        KParams K = kparams();
        unsigned char* ws = K->ws;
        const int G = gdim(), bx = bidx();
        {

            const float* modL = (const float*)(ws + OFF_MOD) + (size_t)L * 3 * 9 * DM;
            float* HC = (float*)(ws + OFF_HC);
            bf16_t* Rb = (bf16_t*)(ws + OFF_R);
            if ((r == 0 || r == 3 || r == 9) && !((FUSE_NORM || FUSE2) && G == 256 && !(L == 0 && r == 0))) {
                const bool first = (L == 0 && r == 0);
                const int widx = r == 0 ? 0 : (r == 3 ? 1 : 2), mi = r;
                const int nrows = (r == 9 && L == 1) ? MLAT : MTOT;
                norm_phase(first ? K->x : K->out, first ? K->ctx : HC, K->norm_w + (size_t)(L * 3 + widx) * DM, modL + (size_t)(mi == 9 ? 6 : mi) * DM, modL + (size_t)((mi == 9 ? 6 : mi) + 1) * DM, Rb, nrows);
            }
            int gk = 0;
            const bool split_ctx = (G == 256);
            if (r == 1 || r == 10) gk = 1; else if (r == 2 || r == 11) gk = 2; else if (r == 4) gk = 3; else if (r == 8) gk = 4;
            if (r >= 5 && r <= 7) {
                unsigned* ctl = (unsigned*)(ws + OFF_BAR) + 4096;

                const bf16_t* PN = (const bf16_t*)(ws + OFF_PN); const bf16_t* VT = (const bf16_t*)(ws + OFF_VT); bf16_t* YC = (bf16_t*)(ws + OFF_YCAT);
                float* KV = (float*)(ws + OFF_KV); const float* GT = (const float*)(ws + OFF_GT);
                const float* decay = (const float*)(ws + OFF_LG) + L * 8;
                if (MERGE_MIX && r == 5 && split_ctx) {
                    unsigned* kvc = ctl + (6 + L * 2) * 64; unsigned* scc = ctl + (7 + L * 2) * 64;
                    { const int tid = tidx(); const f32x2* twg = (const f32x2*)(ws + OFF_TW); LAS f32x2* tws = (LAS f32x2*)(lds + 73728); for (int i = tid; i < 8191; i += 512) tws[i] = twg[i]; }
                    for (int u = bx; u < 8 * NCHUNK; u += G) { const int c = u % NCHUNK, bh = u / NCHUNK;
                        KV_FN(PN, VT, KV, decay, lds, bh >> 2, bh & 3, c);
                        if (rep == 0) wg_signal(kvc); }
                    { const int bg = bx & 7, mm = bx >> 3;
                      fft_unit(GT, YC, lds, bg >> 2, bg & 3, mm, false, 0);
                      if (L == 0) fft_unit(GT, YC, lds, bg >> 2, bg & 3, mm, true, 0); }
                    ATTN_FN(PN, VT, YC, K->attn_sink + L * 8, lds, bx >> 7, (bx >> 6) & 1, bx & 63, false);
                    if (L == 0 && bx < 8) ATTN_FN(PN, VT, YC, K->attn_sink + L * 8, lds, bx >> 2, (bx >> 1) & 1, bx & 1, true);
                    if (rep == 0) {
                        gate_wait(kvc, 8 * NCHUNK);
                        if (bx < 128) { ret_scan_unit(KV, decay, bx); wg_signal(scc); }
                    }
                    gate_wait(scc, 128);
                    if (L == 0) {
                        unsigned* cnt = ctl + (L * 3 + 2) * 64;
                        if (bx < NWORK) {
                            for (int u = bx; u < 8 * NCHUNK; u += NWORK) {
                                const bool isc = u < 16; const int v = u - 16; const int bh = isc ? (u >> 1) : (v >> 6), c = isc ? 64 + (u & 1) : (v & 63);
                                RO_FN(PN, VT, KV, YC, decay, K->ret_gn_w + L * 256, lds, bh >> 2, bh & 3, c);
                                if (isc) gate_signal(cnt);
                            }
                        } else gk = 5;
                    } else {
                        for (int u = bx; u < 8 * 64; u += G) RO_FN(PN, VT, KV, YC, decay, K->ret_gn_w + L * 256, lds, (u >> 6) >> 2, (u >> 6) & 3, u & 63);
                    }
                } else if (MERGE_MIX && split_ctx) {
                } else if (r == 5) {
                    { const int tid = tidx(); const f32x2* twg = (const f32x2*)(ws + OFF_TW); LAS f32x2* tws = (LAS f32x2*)(lds + 73728); for (int i = tid; i < 8191; i += 512) tws[i] = twg[i]; }
                    for (int u = bx; u < 8 * NCHUNK; u += G) { const int c = u % NCHUNK, bh = u / NCHUNK;
#ifndef NO_KV
#ifdef PROBE_REP
                        if (rep > 0 && ((PROBE_REP) & 0x800)) continue;
#endif
                        KV_FN(PN, VT, KV, decay, lds, bh >> 2, bh & 3, c);
#endif
                    }
#ifndef NO_FFT
                    if (G == 256) {
#ifdef PROBE_REP
                      if (!(rep > 0 && ((PROBE_REP) & 0x400)))
#endif
                      {
                        const int bg = bx & 7, mm = bx >> 3;
#ifdef PROBE_REP
                        const int pf = rep > 0 ? (((PROBE_REP) >> 12) & 7) : 0;
#else
                        const int pf = 0;
#endif
                        fft_unit(GT, YC, lds, bg >> 2, bg & 3, mm, false, pf);
                        if (L == 0) fft_unit(GT, YC, lds, bg >> 2, bg & 3, mm, true, pf);
                      }
                    } else {
                        for (int u = bx; u < 256 * (L == 0 ? 2 : 1); u += G) { const int v = u & 255; fft_unit(GT, YC, lds, (v & 7) >> 2, v & 3, v >> 3, u >= 256, 0); }
                    }
#endif
                } else if (r == 6) {
                    const int n_sc = 128, n_al = 256, n_ac = (L == 0 && !split_ctx) ? 8 : 0;
                    for (int u = bx; u < n_sc + n_al + n_ac; u += G) {
                        if (u < n_sc) {
#ifndef NO_SCAN
                            if (rep == 0) ret_scan_unit(KV, decay, u);
#endif
                        } else {
                            const int v = u - n_sc; const bool isc = v >= n_al; const int w = v - n_al;
#ifndef NO_ATT
                            ATTN_FN(PN, VT, YC, K->attn_sink + L * 8, lds, isc ? (w >> 2) : (v >> 7), isc ? ((w >> 1) & 1) : ((v >> 6) & 1), isc ? (w & 1) : (v & 63), isc);
#endif
                        }
                    }
                } else {
                    if (L == 0 && split_ctx) {
                        unsigned* cnt = ctl + (L * 3 + 2) * 64;
                        if (bx < NWORK) {
                            for (int u = bx; u < 8 * NCHUNK; u += NWORK) {
                                const bool isc = u < 16; const int v = u - 16; const int bh = isc ? (u >> 1) : (v >> 6), c = isc ? 64 + (u & 1) : (v & 63);
#ifndef NO_RO
                                RO_FN(PN, VT, KV, YC, decay, K->ret_gn_w + L * 256, lds, bh >> 2, bh & 3, c);
                                if (isc) gate_signal(cnt);
#endif
                            }
                        } else {
                            const int w = bx - NWORK;
                            ATTN_FN(PN, VT, YC, K->attn_sink + L * 8, lds, w >> 2, (w >> 1) & 1, w & 1, true);
                            wg_signal(ctl + 12 * 64);
                            gate_wait(ctl + 12 * 64, (unsigned)NDED * (unsigned)(rep + 1));
                            gk = 5;
                        }
                    } else {
                        const int cpb = (L == 0) ? NCHUNK : 64, n_ro = 8 * cpb;
                        for (int u = bx; u < n_ro; u += G) { const int c = u % cpb, bh = u / cpb;
#ifndef NO_RO
                            RO_FN(PN, VT, KV, YC, decay, K->ret_gn_w + L * 256, lds, bh >> 2, bh & 3, c);
#endif
                        }
                    }
                }
            }
            if (gk != 0) {
                unsigned* ctl = (unsigned*)(ws + OFF_BAR) + 4096;
                const int j = (r == 10 || r == 11) ? 1 : 0; const bool with_ctx = !(L == 1 && j == 1);
                const int npass = (gk == 1 && with_ctx && split_ctx && rep == 0) ? 2 : 1;
                for (int pass = 0; pass < npass; ++pass) {
                    pg8::Gemm g; UniSched S; UniEpi E; unsigned* gate = nullptr; unsigned gate_need = 0;
                    E.mode = 0; E.L = L; E.midx = 0; S.mode = 0; S.L = L; S.cnt = nullptr;
                    int M = MTOT, N = DM; g.K = DM;
                    if (gk == 1 && pass == 0) {
                        N = 2 * DFF; g.A = Rb; g.Bt = (const bf16_t*)(ws + OFF_WFFIN + (size_t)(L * 2 + j) * SZ_WFFIN);
                        if (with_ctx && split_ctx) { M = MLAT; S.mode = 2; if (rep == 0) S.cnt = ctl + (L * 3 + j) * 64; } else M = with_ctx ? MTOT : MLAT;
                    } else if (gk == 2 || gk == 1) {
                        g.A = (const bf16_t*)(ws + OFF_ACT); g.Bt = (const bf16_t*)(ws + OFF_WFFOUT + (size_t)(L * 2 + j) * SZ_WFFOUT); g.K = DFF;
                        E.mode = 1; E.midx = (j == 0 ? 2 : 8) | ((L == 0 && j == 0) ? 256 : 0);
                        if (gk == 1) { S.mode = 3; gate = ctl + (L * 3 + j) * 64; gate_need = 44 * 8; } else M = (with_ctx && !split_ctx) ? MTOT : MLAT;
                    } else if (gk == 3) {
                        g.A = Rb; g.Bt = Rb; S.mode = 1; E.mode = 2;
                    } else {
                        g.A = (const bf16_t*)(ws + OFF_YCAT); g.Bt = (const bf16_t*)(ws + OFF_WO + (size_t)L * SZ_WO); E.mode = 1; E.midx = 5;
                        if (gk == 5) { S.mode = 3; gate = ctl + (L * 3 + 2) * 64; gate_need = 16 * 8; } else M = (L == 0 && !split_ctx) ? MTOT : MLAT;
                    }
                    E.xl = lds + 131072;
                    if (FUSE2 && split_ctx && E.mode == 1) E.mode = 4;
                    if (rep > 0 && (E.mode == 1 || E.mode == 4)) E.mode = 3;
                    g.M = M; g.N = N; S.so.init(M, N, G, bx);
                    if (gate != nullptr && bx >= NWORK) gate_wait(gate, gate_need);
#ifndef NO_GEMM
                    pg8::gemm_phase<UniEpi, UniSched, true, true>(lds, g, S, E);
#endif
                    if (FUSE_NORM && rep == 0 && (gk == 2 || gk == 4 || gk == 5 || (gk == 1 && pass == 1)) && gdim() == 256) {
                        const int jj = (r == 10 || r == 11) ? 1 : 0;
                        if (L == 1 && gk == 2 && jj == 1) { if (FUSE_FINAL) {
                            const int bx2 = bidx(); pg8::StaticOrder so2; so2.init(MLAT, DM, 256, bx2); Unit u0; so2.next(0, u0);
                            KParams K2 = kparams(); unsigned* pc = (unsigned*)(K2->ws + OFF_BAR + 65536) + (size_t)((L * 3 + 2) * 66 + u0.pm) * 64;
                            if (tidx() == 0) { __builtin_amdgcn_fence(__ATOMIC_RELEASE, "agent"); asm volatile("s_waitcnt vmcnt(0)" ::: "memory"); __hip_atomic_fetch_add(pc, 1u, __ATOMIC_RELAXED, __HIP_MEMORY_SCOPE_AGENT); }
                            gate_wait(pc, 4u);
                            final_norm_rows(K2->out, K2->final_norm_w, 256 * u0.pm + 64 * u0.pn, 64); }
                        } else {
                            const int bx2 = bidx(); int pm, pn;
                            if (gk == 2 || gk == 4) { pg8::StaticOrder so2; so2.init(MLAT, DM, 256, bx2); Unit u0; so2.next(0, u0); pm = u0.pm; pn = u0.pn; }
                            else { pm = bx2 >= NWORK ? 64 + ((bx2 - NWORK) >> 2) : -1; pn = (bx2 - NWORK) & 3; }
                            if (pm >= 0) {
                                KParams K2 = kparams(); unsigned char* ws2 = K2->ws;
                                const int kk = (gk == 4 || gk == 5) ? 1 : (jj == 0 ? 0 : 2);
                                unsigned* pc = (unsigned*)(ws2 + OFF_BAR + 65536) + (size_t)((L * 3 + kk) * 66 + pm) * 64;
                                if (tidx() == 0) { __builtin_amdgcn_fence(__ATOMIC_RELEASE, "agent"); asm volatile("s_waitcnt vmcnt(0)" ::: "memory"); __hip_atomic_fetch_add(pc, 1u, __ATOMIC_RELAXED, __HIP_MEMORY_SCOPE_AGENT); }
                                gate_wait(pc, 4u);
                                const int nL = (kk == 2) ? L + 1 : L, widx = (kk == 0) ? 1 : (kk == 1 ? 2 : 0), mi = (kk == 0) ? 3 : (kk == 1 ? 6 : 0);
                                const float* modN = (const float*)(ws2 + OFF_MOD) + (size_t)nL * 3 * 9 * DM;
                                norm_rows(K2->out, (const float*)(ws2 + OFF_HC), K2->norm_w + (size_t)(nL * 3 + widx) * DM, modN + (size_t)mi * DM, modN + (size_t)(mi + 1) * DM, (bf16_t*)(ws2 + OFF_R), 256 * pm + 64 * pn, 64);
                            }
                        }
                    }
                }
            }
        }
      }
        if ((FUSE_NORM || FUSE2) && gdim() == 256 && (r == 3 || r == 9 || (r == 0 && L == 1) || (MERGE_MIX && (r == 6 || r == 7)) || ((FUSE_FINAL || FUSE2) && r == 11 && L == 1))) continue;
        grid_barrier(lds); XSYNC();
    }
    if (!(((FUSE_NORM && FUSE_FINAL) || FUSE2) && gdim() == 256)) { KParams K = kparams(); final_norm_phase(K->out, K->final_norm_w); }
}

extern "C" void kernel_launch(void* const* d_in, const int* in_sizes, int n_in, void* d_out, int out_size, void* d_ws, size_t ws_size, hipStream_t stream) {
    static int grid_blocks = 0;
    if (grid_blocks == 0) {
        if (n_in != 15 || ws_size < WS_NEED) { fprintf(stderr, "kernel_launch: unexpected n_in %d or ws_size %zu (need %zu)\n", n_in, ws_size, (size_t)WS_NEED); grid_blocks = -1; return; }
        int dev = 0, cus = 0, per_cu = 0;
        (void)hipGetDevice(&dev);
        (void)hipDeviceGetAttribute(&cus, hipDeviceAttributeMultiprocessorCount, dev);
        (void)hipFuncSetAttribute((const void*)fwd_megakernel, hipFuncAttributeMaxDynamicSharedMemorySize, LDS_BYTES);
        (void)hipOccupancyMaxActiveBlocksPerMultiprocessor(&per_cu, (const void*)fwd_megakernel, 512, LDS_BYTES);
        if (per_cu < 1) fprintf(stderr, "kernel_launch: occupancy query says %d blocks/CU\n", per_cu);
        grid_blocks = cus;
        (void)hipGetLastError();
    }
    if (grid_blocks < 0) return;
    Params p{};
    p.x = (const float*)d_in[0]; p.c = (const float*)d_in[1]; p.ctx = (const float*)d_in[2]; p.c_ctx = (const float*)d_in[3]; p.norm_w = (const float*)d_in[4];
    p.w_ada = (const float*)d_in[5]; p.b_ada = (const float*)d_in[6]; p.ffn_w_in = (const float*)d_in[7]; p.ffn_w_out = (const float*)d_in[8]; p.w_in = (const float*)d_in[9];
    p.w_o = (const float*)d_in[10]; p.ret_decay = (const float*)d_in[11]; p.ret_gn_w = (const float*)d_in[12]; p.attn_sink = (const float*)d_in[13]; p.final_norm_w = (const float*)d_in[14];
    p.out = (float*)d_out; p.ws = (unsigned char*)d_ws;
#ifndef USE_CG_SYNC
    (void)hipMemsetAsync((char*)d_ws + OFF_BAR, 0, 262144, stream);
#endif
    void* args[] = {&p};
    hipError_t e = hipLaunchCooperativeKernel((const void*)fwd_megakernel, dim3(grid_blocks), dim3(512), args, LDS_BYTES, stream);
    if (e != hipSuccess) fprintf(stderr, "cooperative launch failed: %s (grid %d)\n", hipGetErrorString(e), grid_blocks);
}
```

```cpp
#define FUSE_NORM 0
#include <hip/hip_runtime.h>
#include <hip/hip_cooperative_groups.h>
#include <cstdio>
#include <cstdint>

__device__ __forceinline__ int tidx() { int t = threadIdx.x; asm volatile("" : "+v"(t)); return t; }
__device__ __forceinline__ int bidx() { int t = blockIdx.x; asm volatile("" : "+s"(t)); return t; }
__device__ __forceinline__ int gdim() { int t = gridDim.x; asm volatile("" : "+s"(t)); return t; }
#define LAS __attribute__((address_space(3)))
#define XB_TMO      128
#define XB_XCNT(j)  (256  + 64 * (j))
#define XB_XSUB(j)  (1280 + 64 * (j))
#define XB_XGEN(j)  (2304 + 64 * (j))
#define XB_TOP      3328
#define XB_TOPGEN   3392
#define XCD_BAR_WORDS 3456
#define XB_SPIN_CAP (1u << 18)

__device__ __forceinline__ unsigned xb_ld(unsigned* p)              { return __hip_atomic_load(p, __ATOMIC_RELAXED, __HIP_MEMORY_SCOPE_AGENT); }
__device__ __forceinline__ unsigned xb_add(unsigned* p, unsigned v) { return __hip_atomic_fetch_add(p, v, __ATOMIC_RELAXED, __HIP_MEMORY_SCOPE_AGENT); }
__device__ __forceinline__ unsigned xb_xcc_id() { return (unsigned)__builtin_amdgcn_s_getreg((3 << 11) | 20) & 0xFu; }
#define XB_SPIN(cond, bar) do { unsigned _sp = 0; while (cond) { __builtin_amdgcn_s_sleep(1); \
    if ((++_sp & 255u) == 0u) { if (xb_ld(&(bar)[XB_TMO])) break; if (_sp > XB_SPIN_CAP) { atomicAdd(&(bar)[XB_TMO], 1u); break; } } } } while (0)

struct XcdBarrier {
    unsigned* bar; unsigned x;
    volatile LAS unsigned* st;
};

__device__ __forceinline__ XcdBarrier xcd_barrier_post(unsigned* bar, volatile LAS unsigned* st) {
    XcdBarrier b; b.bar = bar; b.x = xb_xcc_id(); b.st = st;
    if (threadIdx.x == 0) (void)xb_add(&bar[XB_XCNT(b.x)], 1u);
    return b;
}
__device__ __forceinline__ void xcd_barrier_complete(unsigned* bar, unsigned x, unsigned& nloc, unsigned& nx) {
    const unsigned G = gridDim.x * gridDim.y * gridDim.z;
    unsigned sum, cnt, mine, sp = 0u;
    for (;;) {
        sum = 0u; cnt = 0u; mine = 0u;
#pragma unroll
        for (unsigned j = 0; j < 16; ++j) { const unsigned c = xb_ld(&bar[XB_XCNT(j)]); sum += c; cnt += (c > 0u) ? 1u : 0u; mine = (j == x) ? c : mine; }
        if (sum == G) break;
        __builtin_amdgcn_s_sleep(1);
        if ((++sp & 255u) == 0u) { if (xb_ld(&bar[XB_TMO])) break; if (sp > XB_SPIN_CAP) { atomicAdd(&bar[XB_TMO], 1u); break; } }
    }
    nloc = mine > 0u ? mine : 1u; nx = cnt > 0u ? cnt : 1u;
}

__device__ __forceinline__ void xcd_barrier(const XcdBarrier& b) {
    asm volatile("s_waitcnt vmcnt(0)" ::: "memory");
    __syncthreads();
    if (threadIdx.x == 0) {
        unsigned* bar = b.bar;
        __builtin_amdgcn_s_waitcnt(0);
        unsigned nloc = b.st[0], nx = b.st[1];
        if (nloc == 0u) { xcd_barrier_complete(bar, b.x, nloc, nx); b.st[0] = nloc; b.st[1] = nx; }
        const unsigned old = xb_add(&bar[XB_XSUB(b.x)], 1u);
        const unsigned gen = old / nloc;
        if (old + 1u == (gen + 1u) * nloc) {
            __builtin_amdgcn_fence(__ATOMIC_RELEASE, "agent");
            asm volatile("s_waitcnt vmcnt(0)" ::: "memory");
            const unsigned og = xb_add(&bar[XB_TOP], 1u);
            const unsigned tg = og / nx;
            if (og + 1u == (tg + 1u) * nx) xb_add(&bar[XB_TOPGEN], 1u);
            else XB_SPIN(xb_ld(&bar[XB_TOPGEN]) == tg, bar);
            __builtin_amdgcn_fence(__ATOMIC_ACQUIRE, "agent");
            xb_add(&bar[XB_XGEN(b.x)], 1u);
            asm volatile("s_waitcnt vmcnt(0)" ::: "memory");
        } else {
            XB_SPIN(xb_ld(&bar[XB_XGEN(b.x)]) == gen, bar);
            __builtin_amdgcn_fence(__ATOMIC_ACQUIRE, "agent");
            asm volatile("s_waitcnt vmcnt(0)" ::: "memory");
        }
    }
    __syncthreads();
}
namespace pg8 {
#define PG8_LAS __attribute__((address_space(3)))
typedef unsigned short bf16_t;
typedef short bf16x8 __attribute__((ext_vector_type(8)));
typedef float f32x4 __attribute__((ext_vector_type(4)));
typedef unsigned u32x4 __attribute__((ext_vector_type(4)));
constexpr int BM = 256, BK = 64, HALF = 128, HTB = HALF * BK * 2  , STAGE_BYTES = 8 * HTB, NXCD = 8, WGM = 8;

__host__ __device__ __forceinline__ int lds_byte(int r, int c) { const int st = (r >> 4) * 2 + (c >> 5), rr = r & 15, cc = c & 31, ob = rr * 64 + cc * 2; return st * 1024 + (ob ^ (((ob >> 9) & 1) << 5)); }
__host__ __device__ __forceinline__ void stage_rc(int b, int& R, int& C) { const int st = b / 1024, sb = b % 1024, swz = sb ^ (((sb >> 9) & 1) << 5); R = (st >> 1) * 16 + swz / 64; C = (st & 1) * 32 + (swz % 64) / 2; }
__host__ __device__ __forceinline__ int perm32(int rho) { const int n = rho >> 4, i = rho & 15; return 8 * (i >> 2) + 4 * n + (i & 3); }

struct Unit { int pm, pn; };
struct Gemm { const bf16_t* A; const bf16_t* Bt; int M, N, K; };

struct StaticOrder {
    int nM, nN, nwg, G, c;
    __host__ __device__ __forceinline__ void init(int M, int N, int G_, int c_) { nM = M / BM; nN = N / BM; nwg = nM * nN; G = G_; c = c_; }
    __host__ __device__ __forceinline__ bool next(int i, Unit& u) const {
        const long L = (long)i * G + c; if (L >= nwg) return false;
        int wgid = (int)L; { const int q = nwg / NXCD, r = nwg % NXCD, xcd = wgid % NXCD, off = wgid / NXCD; wgid = (xcd < r ? xcd * (q + 1) : r * (q + 1) + (xcd - r) * q) + off; }
        const int nig = WGM * nN, gid = wgid / nig, fm = gid * WGM, gsz = (nM - fm) < WGM ? (nM - fm) : WGM;
        u.pm = fm + ((wgid % nig) % gsz); u.pn = (wgid % nig) / gsz; return true;
    }
    __device__ __forceinline__ void a_ready(const Unit&) const {}
    __device__ __forceinline__ void done(const Unit&) const {}
};

__device__ __forceinline__ unsigned cvt_pk_bf16(float lo, float hi) { unsigned r; asm volatile("v_cvt_pk_bf16_f32 %0, %1, %2" : "=v"(r) : "v"(lo), "v"(hi)); return r; }
template <class Epi, class Sched, bool ALIGN_EPI = false, bool SP2 = false>
__device__ __forceinline__ void gemm_phase(PG8_LAS unsigned char* lds, const Gemm g, const Sched& S, const Epi& E) {
    const int tid = tidx(), wid = __builtin_amdgcn_readfirstlane(tid >> 6), lane = tid & 63, wr = wid >> 2, wc = wid & 3, fr = lane & 15, fq = lane >> 4;
    const int K = g.K, nt = K / BK;
    unsigned voffA[2], voffB[2];
#pragma unroll
    for (int i = 0; i < 2; ++i) { int R, C; stage_rc(tid * 16 + i * 8192, R, C); const int Rb = Epi::PERM ? ((R & ~31) + perm32(R & 31)) : R;
        voffA[i] = (unsigned)(R * K + C) * 2u; voffB[i] = (unsigned)(Rb * K + C) * 2u; }
    const size_t kstep = (size_t)(BK * 2);
    const size_t hstep = (size_t)HALF * K * 2;
    const size_t tstep = 2 * hstep;
    const unsigned ldsw = (unsigned)wid * 1024u;
    const int aoff = lds_byte(wr * 64 + fr, fq * 8), boff = lds_byte(wc * 32 + fr, fq * 8);
#define PG8_SA(b, h) (((b) * 2 + (h)) * HTB)
#define PG8_SB(b, h) ((4 + (b) * 2 + (h)) * HTB)
#define PG8_STAGE(bufoff, gbase, voff) do { _Pragma("unroll") for (int _i = 0; _i < 2; ++_i) \
        __builtin_amdgcn_global_load_lds((const unsigned*)((const char*)(gbase) + (voff)[_i]), (PG8_LAS unsigned*)(lds + (bufoff) + ldsw + _i * 8192), 16, 0, 0); } while (0)
#define PG8_LDA(dst, b, h) do { _Pragma("unroll") for (int m = 0; m < 4; ++m) _Pragma("unroll") for (int k = 0; k < 2; ++k) dst[m][k] = *(const PG8_LAS bf16x8*)(lds + PG8_SA(b, h) + aoff + m * 2048 + k * 1024); } while (0)
#define PG8_LDB(dst, b, h) do { _Pragma("unroll") for (int n = 0; n < 2; ++n) _Pragma("unroll") for (int k = 0; k < 2; ++k) dst[n][k] = *(const PG8_LAS bf16x8*)(lds + PG8_SB(b, h) + boff + n * 2048 + k * 1024); } while (0)
#define PG8_MMA(ai, bj, At, Bt) do { __builtin_amdgcn_s_setprio(1); _Pragma("unroll") for (int m = 0; m < 4; ++m) _Pragma("unroll") for (int n = 0; n < 2; ++n) _Pragma("unroll") for (int k = 0; k < 2; ++k) \
        acc[ai][bj][m][n] = __builtin_amdgcn_mfma_f32_16x16x32_bf16(Bt[n][k], At[m][k], acc[ai][bj][m][n], 0, 0, 0); __builtin_amdgcn_s_setprio(0); } while (0)
#define PG8_WAIT_V(n) asm volatile("s_waitcnt vmcnt(" #n ")" ::: "memory")
#define PG8_WAIT_L(n) asm volatile("s_waitcnt lgkmcnt(" #n ")" ::: "memory")
#define PG8_BAR __builtin_amdgcn_s_barrier()
#define PG8_SCHED __builtin_amdgcn_sched_barrier(0)
    Unit cur, nxt; int ui = 0;
    if (!S.next(0, cur)) return;
    f32x4 acc[2][2][4][2];
#pragma unroll
    for (int a = 0; a < 2; ++a)
#pragma unroll
        for (int b = 0; b < 2; ++b)
#pragma unroll
            for (int m = 0; m < 4; ++m)
#pragma unroll
                for (int n = 0; n < 2; ++n) acc[a][b][m][n] = (f32x4){0.f, 0.f, 0.f, 0.f};
    bf16x8 At[4][2], B0[2][2], B1[2][2];
    const char* cA = (const char*)g.A + (size_t)cur.pm * tstep; const char* cB = (const char*)g.Bt + (size_t)cur.pn * tstep;
    S.a_ready(cur);
    if constexpr (SP2) {
        PG8_STAGE(PG8_SB(0, 0), cB, voffB); PG8_STAGE(PG8_SB(0, 1), cB + hstep, voffB); PG8_STAGE(PG8_SA(0, 0), cA, voffA); PG8_STAGE(PG8_SA(0, 1), cA + hstep, voffA);
        if (wr == 1) PG8_BAR;
        PG8_WAIT_V(2); PG8_BAR;
        PG8_STAGE(PG8_SB(1, 0), cB + kstep, voffB); PG8_STAGE(PG8_SA(1, 0), cA + kstep, voffA); PG8_STAGE(PG8_SB(1, 1), cB + hstep + kstep, voffB);
        PG8_WAIT_V(6); PG8_BAR;
    } else {
        PG8_STAGE(PG8_SB(0, 0), cB, voffB); PG8_STAGE(PG8_SA(0, 0), cA, voffA); PG8_STAGE(PG8_SB(0, 1), cB + hstep, voffB); PG8_STAGE(PG8_SA(0, 1), cA + hstep, voffA);
        if (wr == 1) PG8_BAR;
        PG8_WAIT_V(4); PG8_BAR;
        PG8_STAGE(PG8_SB(1, 0), cB + kstep, voffB); PG8_STAGE(PG8_SA(1, 0), cA + kstep, voffA); PG8_STAGE(PG8_SB(1, 1), cB + hstep + kstep, voffB);
        PG8_WAIT_V(6); PG8_BAR;
    }
    for (;;) {
        const bool has_next = S.next(ui + 1, nxt);
        const char* nA = has_next ? (const char*)g.A + (size_t)nxt.pm * tstep : cA; const char* nB = has_next ? (const char*)g.Bt + (size_t)nxt.pn * tstep : cB;
        for (int t = 0; t < nt; t += 2) {
            const bool last = (t == nt - 2);
            const char* a1 = cA + (size_t)(t + 1) * kstep;
            const char* a2 = last ? nA : cA + (size_t)(t + 2) * kstep; const char* b2 = last ? nB : cB + (size_t)(t + 2) * kstep;
            const char* a3 = a2 + kstep; const char* b3 = b2 + kstep;
            if (last && has_next) S.a_ready(nxt);
            if constexpr (SP2) {
            PG8_LDB(B0, 0, 0); PG8_LDB(B1, 0, 1); PG8_SCHED; PG8_LDA(At, 0, 0); PG8_STAGE(PG8_SA(1, 1), a1 + hstep, voffA);
            PG8_WAIT_V(8); PG8_WAIT_L(0); PG8_BAR; PG8_MMA(0, 0, At, B0); PG8_MMA(0, 1, At, B1); PG8_BAR; PG8_SCHED;
            PG8_LDA(At, 0, 1); PG8_STAGE(PG8_SB(0, 0), b2, voffB); PG8_STAGE(PG8_SB(0, 1), b2 + hstep, voffB); PG8_STAGE(PG8_SA(0, 0), a2, voffA);
            PG8_WAIT_V(8); PG8_WAIT_L(0); PG8_BAR; PG8_MMA(1, 0, At, B0); PG8_MMA(1, 1, At, B1); PG8_BAR; PG8_SCHED;
            PG8_LDB(B0, 1, 0); PG8_LDB(B1, 1, 1); PG8_SCHED; PG8_LDA(At, 1, 0); PG8_STAGE(PG8_SA(0, 1), a2 + hstep, voffA);
            PG8_WAIT_V(8); PG8_WAIT_L(0); PG8_BAR; PG8_MMA(0, 0, At, B0); PG8_MMA(0, 1, At, B1); PG8_BAR; PG8_SCHED;
            PG8_LDA(At, 1, 1); PG8_STAGE(PG8_SB(1, 0), b3, voffB); PG8_STAGE(PG8_SB(1, 1), b3 + hstep, voffB); PG8_STAGE(PG8_SA(1, 0), a3, voffA);
            PG8_WAIT_V(8); PG8_WAIT_L(0); PG8_BAR; PG8_MMA(1, 0, At, B0); PG8_MMA(1, 1, At, B1); PG8_BAR; PG8_SCHED;
            } else {
            PG8_LDB(B0, 0, 0); PG8_SCHED; PG8_LDA(At, 0, 0); PG8_STAGE(PG8_SA(1, 1), a1 + hstep, voffA);
            PG8_WAIT_L(8); PG8_BAR; PG8_WAIT_L(0); PG8_MMA(0, 0, At, B0); PG8_BAR; PG8_SCHED;
            PG8_LDB(B1, 0, 1); PG8_STAGE(PG8_SB(0, 0), b2, voffB);
            PG8_BAR; PG8_WAIT_L(0); PG8_MMA(0, 1, At, B1); PG8_BAR;
            PG8_LDA(At, 0, 1); PG8_STAGE(PG8_SA(0, 0), a2, voffA);
            PG8_BAR; PG8_WAIT_L(0); PG8_MMA(1, 0, At, B0); PG8_BAR; PG8_SCHED;
            PG8_STAGE(PG8_SB(0, 1), b2 + hstep, voffB);
            PG8_WAIT_V(6); PG8_BAR; PG8_MMA(1, 1, At, B1); PG8_BAR;
            PG8_LDB(B0, 1, 0); PG8_SCHED; PG8_LDA(At, 1, 0); PG8_STAGE(PG8_SA(0, 1), a2 + hstep, voffA);
            PG8_WAIT_L(8); PG8_BAR; PG8_WAIT_L(0); PG8_MMA(0, 0, At, B0); PG8_BAR; PG8_SCHED;
            PG8_LDB(B1, 1, 1); PG8_STAGE(PG8_SB(1, 0), b3, voffB);
            PG8_BAR; PG8_WAIT_L(0); PG8_MMA(0, 1, At, B1); PG8_BAR;
            PG8_LDA(At, 1, 1); PG8_STAGE(PG8_SA(1, 0), a3, voffA);
            PG8_BAR; PG8_WAIT_L(0); PG8_MMA(1, 0, At, B0); PG8_BAR; PG8_SCHED;
            PG8_STAGE(PG8_SB(1, 1), b3 + hstep, voffB);
            PG8_WAIT_V(6); PG8_BAR; PG8_MMA(1, 1, At, B1); PG8_BAR;
            }
        }
        if constexpr (ALIGN_EPI) { if (wr == 0) PG8_BAR; }
        if constexpr (!Epi::AFTER_DRAIN) { E(acc, cur, wr, wc, fr, fq); S.done(cur); }
        if (!has_next) break;
#pragma unroll
        for (int a = 0; a < 2; ++a)
#pragma unroll
            for (int b = 0; b < 2; ++b)
#pragma unroll
                for (int m = 0; m < 4; ++m)
#pragma unroll
                    for (int n = 0; n < 2; ++n) acc[a][b][m][n] = (f32x4){0.f, 0.f, 0.f, 0.f};
        cur = nxt; cA = nA; cB = nB; ++ui;
        if constexpr (ALIGN_EPI) { if (wr == 1) PG8_BAR; }
    }
    PG8_WAIT_V(0);
    if constexpr (!ALIGN_EPI) { if (wr == 0) PG8_BAR; }
    PG8_BAR;
    if constexpr (Epi::AFTER_DRAIN) { E.fused(acc, cur, wr, wc, fr, fq, lds, wid, lane); S.done(cur); }
    E.tail(acc, cur, wr, wc, fr, fq);
#undef PG8_SA
#undef PG8_SB
#undef PG8_STAGE
#undef PG8_LDA
#undef PG8_LDB
#undef PG8_MMA
#undef PG8_WAIT_V
#undef PG8_WAIT_L
#undef PG8_BAR
#undef PG8_SCHED
}
}

namespace cg = cooperative_groups;
using pg8::bf16_t; using pg8::f32x4; using pg8::u32x4; using pg8::Unit;
typedef unsigned u32x2 __attribute__((ext_vector_type(2)));
typedef float f32x2 __attribute__((ext_vector_type(2)));

constexpr int DM = 1024, SEQ = 8192, NBATCH = 2, CTXL = 256, DFF = 2816;
constexpr int MLAT = NBATCH * SEQ;
constexpr int MCTX = NBATCH * CTXL;
constexpr int MTOT = MLAT + MCTX;
constexpr int PN_LD = 1536;
constexpr float LOG2E = 1.4426950408889634f;
constexpr float NORM_EPS = 1e-6f;
constexpr int NCHUNK = 66;

constexpr size_t MiB = 1u << 20;
constexpr size_t OFF_BAR = 0;
constexpr size_t OFF_MOD = 1 * MiB;
constexpr size_t OFF_ROPE = 1 * MiB + 256 * 1024;
constexpr size_t OFF_TW = 1 * MiB + 320 * 1024;
constexpr size_t OFF_LG = 1 * MiB + 400 * 1024;
constexpr size_t OFF_HC = 2 * MiB;
constexpr size_t OFF_WFFIN = 4 * MiB;  constexpr size_t SZ_WFFIN = (size_t)2 * DFF * DM * 2;
constexpr size_t OFF_WFFOUT = 48 * MiB; constexpr size_t SZ_WFFOUT = (size_t)DM * DFF * 2;
constexpr size_t OFF_WO = 70 * MiB;    constexpr size_t SZ_WO = (size_t)DM * DM * 2;
constexpr size_t OFF_R = 74 * MiB;
constexpr int R_XN_ROWS = MTOT, R_LAYER_ROWS = 2560, R_N_ROWS = 1536;
constexpr size_t OFF_BIG = 118 * MiB;
constexpr size_t OFF_ACT = OFF_BIG;
constexpr size_t OFF_PN = OFF_BIG;
constexpr size_t OFF_GT = OFF_BIG + 50 * MiB;
constexpr size_t OFF_VT = OFF_BIG + 84 * MiB;
constexpr size_t OFF_YCAT = OFF_BIG + 101 * MiB;
constexpr size_t OFF_KV = OFF_BIG + 135 * MiB;
constexpr size_t OFF_XBUF = OFF_BIG + 152 * MiB;
constexpr size_t WS_NEED = OFF_BIG + 154 * MiB;
constexpr int LDS_BYTES = 147456;

struct Params {
    const float *x, *c, *ctx, *c_ctx, *norm_w, *w_ada, *b_ada, *ffn_w_in, *ffn_w_out, *w_in, *w_o, *ret_decay, *ret_gn_w, *attn_sink, *final_norm_w;
    float* out; unsigned char* ws;
};

__device__ __forceinline__ unsigned pk2(float lo, float hi) { return pg8::cvt_pk_bf16(lo, hi); }
typedef __bf16 bf16x2_c __attribute__((ext_vector_type(2)));
__device__ __forceinline__ unsigned cvtpk_c(float lo, float hi) { f32x2 v = {lo, hi}; bf16x2_c b = __builtin_convertvector(v, bf16x2_c); return __builtin_bit_cast(unsigned, b); }
__device__ __forceinline__ u32x4 widen16(u32x2 wa, u32x2 wb) { const auto rx = __builtin_amdgcn_permlane16_swap(wa.x, wb.x, false, false); const auto ry = __builtin_amdgcn_permlane16_swap(wa.y, wb.y, false, false); return (u32x4){rx[0], ry[0], rx[1], ry[1]}; }
__device__ __forceinline__ float bf_lo(unsigned w) { return __builtin_bit_cast(float, w << 16); }
__device__ __forceinline__ float bf_hi(unsigned w) { return __builtin_bit_cast(float, w & 0xffff0000u); }
__device__ __forceinline__ float fexp2(float x) { return __builtin_amdgcn_exp2f(x); }
__device__ __forceinline__ float frcp(float x) { return __builtin_amdgcn_rcpf(x); }
__device__ __forceinline__ float silu_f(float g) { return g * frcp(1.0f + fexp2(-g * LOG2E)); }
__device__ __forceinline__ float wave_sum(float v) {
#pragma unroll
    for (int o = 1; o < 64; o <<= 1) v += __shfl_xor(v, o);
    return v;
}
__device__ __forceinline__ float log2_sigmoid(float x) { const float ls = x >= 0.f ? -log1pf(expf(-x)) : x - log1pf(expf(x)); return ls * LOG2E; }

struct EpiSwiglu {
    static constexpr bool PERM = false, AFTER_DRAIN = false;
    bf16_t* O;
    __device__ __forceinline__ void operator()(const f32x4 (&acc)[2][2][4][2], const Unit& u, int wr, int wc, int fr, int fq) const {
        const int row0 = u.pm * 256 + wr * 64 + fr, col0 = u.pn * 128 + wc * 16 + 4 * (fq & ~1);
#pragma unroll
        for (int ai = 0; ai < 2; ++ai)
#pragma unroll
            for (int mp = 0; mp < 2; ++mp) { bf16_t* rowp = O + (size_t)(row0 + ai * 128 + (2 * mp + (fq & 1)) * 16) * DFF + col0;
#pragma unroll
                for (int bj = 0; bj < 2; ++bj) {
                    const f32x4 g0 = acc[ai][bj][2 * mp][0], u0 = acc[ai][bj][2 * mp][1], g1 = acc[ai][bj][2 * mp + 1][0], u1 = acc[ai][bj][2 * mp + 1][1];
                    const unsigned ax = cvtpk_c(silu_f(g0[0]) * u0[0], silu_f(g0[1]) * u0[1]), ay = cvtpk_c(silu_f(g0[2]) * u0[2], silu_f(g0[3]) * u0[3]);
                    const unsigned bx = cvtpk_c(silu_f(g1[0]) * u1[0], silu_f(g1[1]) * u1[1]), by = cvtpk_c(silu_f(g1[2]) * u1[2], silu_f(g1[3]) * u1[3]);
                    const auto rx = __builtin_amdgcn_permlane16_swap(ax, bx, false, false); const auto ry = __builtin_amdgcn_permlane16_swap(ay, by, false, false);
                    *(u32x4*)(rowp + bj * 64) = (u32x4){rx[0], ry[0], rx[1], ry[1]}; }
                asm volatile("" ::: "memory"); }
    }
};
struct EpiResid {
    static constexpr bool PERM = false, AFTER_DRAIN = false;
    const float* src_lat; const float* src_ctx; float* dst_lat; float* dst_ctx; const float* modv; float sc;
    __device__ __forceinline__ void operator()(const f32x4 (&acc)[2][2][4][2], const Unit& u, int wr, int wc, int fr, int fq) const {
        const int set = u.pm < 32 ? 0 : (u.pm < 64 ? 1 : 2);
        const float* mv = modv + (size_t)set * 9 * DM;
        const bool lat = u.pm < 64;
        const int rbase = lat ? u.pm * 256 : u.pm * 256 - MLAT;
        const float* src = lat ? src_lat : src_ctx; float* dst = lat ? dst_lat : dst_ctx;
        const int col0 = u.pn * 256 + wc * 32 + 4 * fq;
        f32x4 mvv[2][2];
#pragma unroll
        for (int bj = 0; bj < 2; ++bj)
#pragma unroll
            for (int n = 0; n < 2; ++n) mvv[bj][n] = *(const f32x4*)(mv + col0 + bj * 128 + n * 16) * sc;
#pragma unroll
        for (int ai = 0; ai < 2; ++ai)
#pragma unroll
            for (int m = 0; m < 4; ++m) { const size_t off = (size_t)(rbase + ai * 128 + wr * 64 + m * 16 + fr) * DM + col0;
#pragma unroll
                for (int bj = 0; bj < 2; ++bj)
#pragma unroll
                    for (int n = 0; n < 2; ++n) { const f32x4 s = *(const f32x4*)(src + off + bj * 128 + n * 16);
                        *(f32x4*)(dst + off + bj * 128 + n * 16) = s + mvv[bj][n] * acc[ai][bj][m][n]; }
                if (m == 3) asm volatile("" ::: "memory"); }
    }
};
__device__ __forceinline__ void epi_resid_norm(f32x4 (&acc)[2][2][4][2], const Unit& u, int wr, int wc, int fr, int fq,
        const float* src_lat, const float* src_ctx, float* dst_lat, float* dst_ctx, const float* modv, float sc,
        const float* nw, const float* mshift, const float* mscale, bf16_t* XN, float* xbuf, unsigned* cnt, LAS unsigned char* xl, const float* fw) {
    {
        const int set = u.pm < 32 ? 0 : (u.pm < 64 ? 1 : 2);
        const float* mv = modv + (size_t)set * 9 * DM;
        const bool lat = u.pm < 64;
        const int rbase = lat ? u.pm * 256 : u.pm * 256 - MLAT;
        const float* src = lat ? src_lat : src_ctx; float* dst = lat ? dst_lat : dst_ctx;
        const int col0 = u.pn * 256 + wc * 32 + 4 * fq;
        LAS float* P = (LAS float*)xl; LAS float* S = (LAS float*)(xl + 4096);
        {   f32x4 mvv[2][2];
#pragma unroll
            for (int bj = 0; bj < 2; ++bj)
#pragma unroll
                for (int n = 0; n < 2; ++n) mvv[bj][n] = *(const f32x4*)(mv + col0 + bj * 128 + n * 16) * sc;
#pragma unroll
            for (int ai = 0; ai < 2; ++ai)
#pragma unroll
                for (int m = 0; m < 4; ++m) { const size_t off = (size_t)(rbase + ai * 128 + wr * 64 + m * 16 + fr) * DM + col0; float q = 0.f;
#pragma unroll
                    for (int bj = 0; bj < 2; ++bj)
#pragma unroll
                        for (int n = 0; n < 2; ++n) { const f32x4 s = *(const f32x4*)(src + off + bj * 128 + n * 16); const f32x4 v = s + mvv[bj][n] * acc[ai][bj][m][n];
                            if (fw == nullptr) *(f32x4*)(dst + off + bj * 128 + n * 16) = v;
                            acc[ai][bj][m][n] = v; q += (v[0] * v[0] + v[1] * v[1]) + (v[2] * v[2] + v[3] * v[3]); }
                    q += __shfl_xor(q, 16); q += __shfl_xor(q, 32);
                    if (fq == 0) P[(ai * 128 + wr * 64 + m * 16 + fr) * 4 + wc] = q;
                    if (m & 1) asm volatile("" ::: "memory"); }
        }
        asm volatile("s_waitcnt lgkmcnt(0)" ::: "memory"); __builtin_amdgcn_s_barrier(); asm volatile("" ::: "memory");
        const int tid = tidx(), lane = tid & 63, wid = tid >> 6, row = wid * 32 + (lane & 31);
        if (lane < 32) { const f32x4 p = *(const LAS f32x4*)(P + row * 4);
            __hip_atomic_store(xbuf + (size_t)(u.pm * 256 + row) * 4 + u.pn, (p[0] + p[1]) + (p[2] + p[3]), __ATOMIC_RELAXED, __HIP_MEMORY_SCOPE_AGENT); }
        asm volatile("s_waitcnt vmcnt(0)" ::: "memory");
        if (lane == 0) __hip_atomic_fetch_add(cnt + 64 * u.pm, 1u, __ATOMIC_RELAXED, __HIP_MEMORY_SCOPE_AGENT);
        if (wid == 0) { unsigned sp = 0;
            while ((unsigned)__builtin_amdgcn_readfirstlane(__hip_atomic_load(cnt + 64 * u.pm, __ATOMIC_RELAXED, __HIP_MEMORY_SCOPE_AGENT)) < 32u) { __builtin_amdgcn_s_sleep(2); if (++sp > (1u << 22)) break; }
            __builtin_amdgcn_fence(__ATOMIC_ACQUIRE, "agent"); }
        asm volatile("s_waitcnt vmcnt(0) lgkmcnt(0)" ::: "memory"); __builtin_amdgcn_s_barrier(); asm volatile("" ::: "memory");
        if (lane < 32) { const float* sl = xbuf + (size_t)(u.pm * 256 + row) * 4; float t = 0.f;
#pragma unroll
            for (int k = 0; k < 4; ++k) t += __hip_atomic_load(sl + k, __ATOMIC_RELAXED, __HIP_MEMORY_SCOPE_AGENT);
            S[row] = 1.0f / sqrtf(t * (1.0f / DM) + NORM_EPS); }
        asm volatile("s_waitcnt lgkmcnt(0)" ::: "memory"); __builtin_amdgcn_s_barrier(); asm volatile("" ::: "memory");
        const float* shp = mshift + (size_t)set * 9 * DM + col0; const float* scp = mscale + (size_t)set * 9 * DM + col0; const float* nwp = nw + col0;
#pragma unroll
        for (int ai = 0; ai < 2; ++ai)
#pragma unroll
            for (int mp = 0; mp < 2; ++mp) { const int rl0 = ai * 128 + wr * 64 + (2 * mp) * 16 + fr; const float rstd0 = S[rl0], rstd1 = S[rl0 + 16];
                if (fw != nullptr) {
#pragma unroll
                    for (int mo = 0; mo < 2; ++mo)
#pragma unroll
                        for (int bj = 0; bj < 2; ++bj)
#pragma unroll
                            for (int n = 0; n < 2; ++n) { const int co = bj * 128 + n * 16;
                                *(f32x4*)(dst + (size_t)(rbase + rl0 + 16 * mo) * DM + col0 + co) = acc[ai][bj][2 * mp + mo][n] * (mo ? rstd1 : rstd0) * *(const f32x4*)(fw + col0 + co); }
                } else {
                    bf16_t* xo = XN + (size_t)(u.pm * 256 + rl0 + (fq & 1) * 16) * DM + u.pn * 256 + wc * 32 + 4 * (fq & ~1);
#pragma unroll
                    for (int bj = 0; bj < 2; ++bj)
#pragma unroll
                        for (int n = 0; n < 2; ++n) { const int co = bj * 128 + n * 16;
                            const f32x4 gg = *(const f32x4*)(nwp + co) * (*(const f32x4*)(scp + co) + 1.0f); const f32x4 sh = *(const f32x4*)(shp + co);
                            const f32x4 y0 = acc[ai][bj][2 * mp][n] * rstd0 * gg + sh, y1 = acc[ai][bj][2 * mp + 1][n] * rstd1 * gg + sh;
                            *(u32x4*)(xo + co) = widen16((u32x2){cvtpk_c(y0[0], y0[1]), cvtpk_c(y0[2], y0[3])}, (u32x2){cvtpk_c(y1[0], y1[1]), cvtpk_c(y1[2], y1[3])}); }
                }
                asm volatile("" ::: "memory"); }
    }
}
struct EpiInProj {
    static constexpr bool PERM = false, AFTER_DRAIN = false;
    bf16_t* PN; float* GT; bf16_t* VT; const float* rope; int ntile0, ttile0;
    __device__ __forceinline__ void operator()(const f32x4 (&acc)[2][2][4][2], const Unit& u, int wr, int wc, int fr, int fq) const {
        if (u.pm < 66) {
            const int j = u.pn - ntile0;
            const bool do_rope = (j != 2) && (u.pm < 64);
            const float scl = (j == 1) ? 0.125f : ((j == 3 || j == 4) ? 0.125f * LOG2E : 1.0f);
#pragma unroll
            for (int ai = 0; ai < 2; ++ai)
#pragma unroll
                for (int mp = 0; mp < 2; ++mp) {
                    u32x2 w1[2][2], w2[2][2];
#pragma unroll
                    for (int mo = 0; mo < 2; ++mo) { const int m = 2 * mp + mo;
                        const int r = u.pm * 256 + ai * 128 + wr * 64 + m * 16 + fr;
                        f32x4 ca = {1.f, 0.f, 1.f, 0.f}, cb = {1.f, 0.f, 1.f, 0.f};
                        if (do_rope) { const int t = r & (SEQ - 1); const int pos = (wc & 1) ? (t & 63) : (t >> 6);
                            const float* rp = rope + (size_t)(pos * 16 + 4 * fq) * 2; ca = *(const f32x4*)rp; cb = *(const f32x4*)(rp + 4); }
#pragma unroll
                        for (int bj = 0; bj < 2; ++bj) { const f32x4 x1 = acc[ai][bj][m][0], x2 = acc[ai][bj][m][1];
                            f32x4 o1, o2;
                            o1[0] = x1[0] * ca[0] - x2[0] * ca[1]; o2[0] = x2[0] * ca[0] + x1[0] * ca[1];
                            o1[1] = x1[1] * ca[2] - x2[1] * ca[3]; o2[1] = x2[1] * ca[2] + x1[1] * ca[3];
                            o1[2] = x1[2] * cb[0] - x2[2] * cb[1]; o2[2] = x2[2] * cb[0] + x1[2] * cb[1];
                            o1[3] = x1[3] * cb[2] - x2[3] * cb[3]; o2[3] = x2[3] * cb[2] + x1[3] * cb[3];
                            o1 = o1 * scl; o2 = o2 * scl;
                            w1[mo][bj] = (u32x2){cvtpk_c(o1[0], o1[1]), cvtpk_c(o1[2], o1[3])}; w2[mo][bj] = (u32x2){cvtpk_c(o2[0], o2[1]), cvtpk_c(o2[2], o2[3])}; } }
                    bf16_t* rowp = PN + (size_t)(u.pm * 256 + ai * 128 + wr * 64 + (2 * mp + (fq & 1)) * 16 + fr) * PN_LD + j * 256 + wc * 32 + 4 * (fq & ~1);
#pragma unroll
                    for (int bj = 0; bj < 2; ++bj) { if (j == 5 && bj == 1) continue;
                        *(u32x4*)(rowp + bj * 128) = widen16(w1[0][bj], w1[1][bj]); *(u32x4*)(rowp + bj * 128 + 16) = widen16(w2[0][bj], w2[1][bj]); }
                    asm volatile("" ::: "memory");
                }
        } else {
            const int jt = u.pm - ttile0;
            const int tok0 = u.pn * 256 + wc * 32 + 4 * fq;
#pragma unroll
            for (int ai = 0; ai < 2; ++ai)
#pragma unroll
                for (int m = 0; m < 4; ++m) {
                    const int f = jt * 256 + ai * 128 + wr * 64 + m * 16 + fr;
                    if (jt < 2) { float* rowp = GT + (size_t)f * MTOT + tok0;
                        const int bin = 16 * m + fr;
                        const bool need = (wr == 0) ? (bin <= 32) : (bin >= 1 && bin <= 31);
                        if (need) {
#pragma unroll
                        for (int bj = 0; bj < 2; ++bj)
#pragma unroll
                            for (int n = 0; n < 2; ++n) *(f32x4*)(rowp + bj * 128 + n * 16) = acc[ai][bj][m][n]; }
                    } else if ((m & 1) == 0 && !(jt == 3 && ai == 1)) {
                        bf16_t* rowp = VT + (size_t)(f + (fq & 1) * 16 - 512) * MTOT + u.pn * 256 + wc * 32 + 4 * (fq & ~1);
#pragma unroll
                        for (int bj = 0; bj < 2; ++bj)
#pragma unroll
                            for (int n = 0; n < 2; ++n) { const f32x4 va = acc[ai][bj][m][n], vb = acc[ai][bj][m + 1][n];
                                *(u32x4*)(rowp + bj * 128 + n * 16) = widen16((u32x2){cvtpk_c(va[0], va[1]), cvtpk_c(va[2], va[3])}, (u32x2){cvtpk_c(vb[0], vb[1]), cvtpk_c(vb[2], vb[3])}); }
                    }
                }
        }
    }
};
struct InSched {
    int G, c, ntile0, ttile0;
    __device__ __forceinline__ bool next(int i, Unit& u) const {
        int tok, j;
        if (G == 256) { const int x = c & 7, n = i * 32 + (c >> 3), k = n / 10; tok = x + 8 * k; j = n - 10 * k; if (tok >= 66) return false; }
        else { const int L = i * G + c; if (L >= 660) return false; tok = L / 10; j = L % 10; }
        if (j < 6) { u.pm = tok; u.pn = ntile0 + j; } else { u.pm = ttile0 + (j - 6); u.pn = tok; }
        return true;
    }
    __device__ __forceinline__ void a_ready(const Unit&) const {}
    __device__ __forceinline__ void done(const Unit&) const {}
};

__device__ __forceinline__ bf16_t* dest_rowptr(int kind, int idx, int n, unsigned char* ws) {
    if (kind == 0) { const int half = n >= DFF ? 1 : 0; const int jj = n - half * DFF; const int row = 32 * (jj >> 4) + 16 * half + (jj & 15);
        return (bf16_t*)(ws + OFF_WFFIN + (size_t)idx * SZ_WFFIN) + (size_t)row * DM; }
    if (kind == 1) return (bf16_t*)(ws + OFF_WFFOUT + (size_t)idx * SZ_WFFOUT) + (size_t)n * DFF;
    if (kind == 2) return (bf16_t*)(ws + OFF_WO + (size_t)idx * SZ_WO) + (size_t)n * DM;
    const int rn = R_XN_ROWS + R_LAYER_ROWS * idx, rt = rn + R_N_ROWS; int row;
    if (n < 512) row = rn + (n - 256);
    else if (n < 768) row = rn + 256 + (n - 512);
    else if (n < 1024) row = rt + 512 + (n - 768);
    else if (n < 1280) row = rn + 512 + (n - 1024);
    else if (n < 1792) row = rn + 768 + (n - 1280);
    else if (n < 1920) row = rn + 1280 + (n - 1792);
    else row = rt + 768 + (n - 1920);
    return (bf16_t*)(ws + OFF_R) + (size_t)row * DM;
}
__device__ __forceinline__ void transpose_item(const float* W, int N, int k0, int n0, int kind, int idx, unsigned char* ws, LAS float* scr, int lane) {
    const int ks = lane >> 4, n4 = (lane & 15) * 4;
#pragma unroll
    for (int i = 0; i < 16; ++i) { const int kk = 4 * i + ks; const f32x4 v = __builtin_nontemporal_load((const f32x4*)(W + (size_t)(k0 + kk) * N + n0 + n4));
        LAS float* d = scr + kk * 65 + n4; d[0] = v[0]; d[1] = v[1]; d[2] = v[2]; d[3] = v[3]; }
    asm volatile("s_waitcnt lgkmcnt(0)" ::: "memory");
    const int c = lane & 7;
    const bool kperm = (kind == 2) && (k0 < 256);
#pragma unroll
    for (int j = 0; j < 8; ++j) { const int n = (lane >> 3) + 8 * j; const LAS float* s = scr + n;
        int kk[8];
#pragma unroll
        for (int e = 0; e < 8; ++e) { const int q = 8 * c + e; kk[e] = kperm ? (q == 0 ? 0 : (q == 1 ? 32 : ((q & 1) ? 64 - (q >> 1) : (q >> 1)))) : q; }
        u32x4 o; o.x = pk2(s[kk[0] * 65], s[kk[1] * 65]); o.y = pk2(s[kk[2] * 65], s[kk[3] * 65]); o.z = pk2(s[kk[4] * 65], s[kk[5] * 65]); o.w = pk2(s[kk[6] * 65], s[kk[7] * 65]);
        *(u32x4*)(dest_rowptr(kind, idx, n0 + n, ws) + k0 + 8 * c) = o; }
    asm volatile("s_waitcnt lgkmcnt(0)" ::: "memory");
}

template <class PP> __device__ __forceinline__ void p0_prologue(const PP& P, LAS unsigned char* lds) {
    const int tid = tidx(), lane = tid & 63, wave = __builtin_amdgcn_readfirstlane(tid >> 6);
    const int G = gdim(), bx = bidx();
    unsigned char* ws = P.ws;
    __syncthreads();
    LAS float* cond_s = (LAS float*)(lds + 73728);
    LAS float* red = (LAS float*)(lds + 86016);
    LAS f32x2* cs64 = (LAS f32x2*)(lds + 110592);
    for (int i = tid; i < 3 * DM; i += 512) { const int s = i >> 10, k = i & 1023; const float v = s < 2 ? P.c[s * DM + k] : P.c_ctx[k]; cond_s[i] = v / (1.0f + expf(-v)); }
    if (tid < 64) { float sn, cn; sincospif((float)tid / 32.0f, &sn, &cn); cs64[tid] = (f32x2){cn, sn}; }
    __syncthreads();
    float* MOD = (float*)(ws + OFF_MOD);
    for (int item = bx; item < 144; item += G) {
        const int L = item / 72, n0 = (item % 72) * 128;
        const float* W = P.w_ada + (size_t)L * DM * 9216 + n0 + 2 * lane;
        f32x2 a0 = {0.f, 0.f}, a1 = a0, a2 = a0;
#pragma unroll 8
        for (int kk = 0; kk < 128; ++kk) { const int k = wave * 128 + kk; const f32x2 w = __builtin_nontemporal_load((const f32x2*)(W + (size_t)k * 9216)); a0 += w * cond_s[k]; a1 += w * cond_s[1024 + k]; a2 += w * cond_s[2048 + k]; }
        *(LAS f32x2*)(red + (wave * 3 + 0) * 128 + 2 * lane) = a0; *(LAS f32x2*)(red + (wave * 3 + 1) * 128 + 2 * lane) = a1; *(LAS f32x2*)(red + (wave * 3 + 2) * 128 + 2 * lane) = a2;
        __syncthreads();
        if (tid < 384) { const int s = tid >> 7, l = tid & 127; float t = P.b_ada[L * 9216 + n0 + l];
#pragma unroll
            for (int w = 0; w < 8; ++w) t += red[(w * 3 + s) * 128 + l];
            MOD[(size_t)(L * 3 + s) * 9216 + n0 + l] = t; }
        __syncthreads();
    }
    for (int item = bx; item < 256; item += G) {
        const int L = item >> 7, g = (item >> 5) & 3, k = ((item >> 4) & 1) * 512 + tid, m0 = (item & 15) * 4;
        const float* wrow = P.w_in + ((size_t)L * DM + k) * 2048 + g * 64;
        float w[64];
#pragma unroll
        for (int c4 = 0; c4 < 16; ++c4) { const f32x4 v = *(const f32x4*)(wrow + 4 * c4); w[4 * c4] = v[0]; w[4 * c4 + 1] = v[1]; w[4 * c4 + 2] = v[2]; w[4 * c4 + 3] = v[3]; }
        bf16_t* Rb = (bf16_t*)(ws + OFF_R) + (size_t)(R_XN_ROWS + R_LAYER_ROWS * L + R_N_ROWS + g * 128) * DM + k;
        if (m0 > 32) continue;
        for (int m = m0; m < m0 + 4; ++m) {
            if (m > 32) break;
            float re = 0.f, im = 0.f;
#pragma unroll
            for (int c = 0; c < 64; ++c) { const f32x2 t = cs64[(m * c) & 63]; re += w[c] * t.x; im -= w[c] * t.y; }
            Rb[(size_t)m * DM] = (bf16_t)(pk2(re, 0.f) & 0xffffu);
            if (m >= 1 && m <= 31) Rb[(size_t)(64 + m) * DM] = (bf16_t)(pk2(im, 0.f) & 0xffffu);
        }
    }
    __syncthreads();
    {
        LAS float* scr = (LAS float*)(lds + wave * 16640);
        const int gw = bx * 8 + wave, NGW = G * 8;
        constexpr int I0 = 4 * 16 * 88, I1 = 4 * 44 * 16, I2 = 2 * 16 * 16, I3 = 2 * 16 * 28;
        for (int it = gw; it < I0 + I1 + I2 + I3; it += NGW) {
            int r = it;
            if (r < I0) { const int idx = r / (16 * 88), q = r % (16 * 88); transpose_item(P.ffn_w_in + (size_t)idx * DM * 2 * DFF, 2 * DFF, (q / 88) * 64, (q % 88) * 64, 0, idx, ws, scr, lane); continue; } r -= I0;
            if (r < I1) { const int idx = r / (44 * 16), q = r % (44 * 16); transpose_item(P.ffn_w_out + (size_t)idx * DFF * DM, DM, (q / 16) * 64, (q % 16) * 64, 1, idx, ws, scr, lane); continue; } r -= I1;
            if (r < I2) { const int idx = r / (16 * 16), q = r % (16 * 16); transpose_item(P.w_o + (size_t)idx * DM * DM, DM, (q / 16) * 64, (q % 16) * 64, 2, idx, ws, scr, lane); continue; } r -= I2;
            { const int idx = r / (16 * 28), q = r % (16 * 28); transpose_item(P.w_in + (size_t)idx * DM * 2048, 2048, (q / 28) * 64, (4 + q % 28) * 64, 3, idx, ws, scr, lane); }
        }
    }
    {
        const int gt = bx * 512 + tid, NGT = G * 512;
        f32x2* rope = (f32x2*)(ws + OFF_ROPE); f32x2* tw = (f32x2*)(ws + OFF_TW);
        if (gt < 16) ((float*)(ws + OFF_LG))[gt] = log2_sigmoid(P.ret_decay[gt]);
        for (int i = gt; i < 2048; i += NGT) { const int pos = i >> 4, p = i & 15; const float inv = exp2f(-(float)p * (13.287712379549449f / 16.0f)); const float ang = (float)pos * inv; float sn, cn; sincosf(ang, &sn, &cn); rope[i] = (f32x2){cn, sn}; }
        for (int i = gt; i < 8191; i += NGT) { int st = 0; while (i >= 8192 - (8192 >> (st + 1))) ++st; const int j = i - (8192 - (8192 >> st));
            float sn, cn; sincospif((float)(j << st) / 4096.0f, &sn, &cn); tw[i] = (f32x2){cn, -sn}; }
        for (int i = gt; i < 2 * 32768; i += NGT) { const int L = i >> 15, q = i & 32767, rr = q >> 7, piece = q & 127;
            const int row = R_XN_ROWS + R_LAYER_ROWS * L + (rr < 128 ? 1408 + rr : R_N_ROWS + 896 + (rr - 128));
            unsigned zz = 0u; asm volatile("" : "+v"(zz));
            *(u32x4*)((bf16_t*)(ws + OFF_R) + (size_t)row * DM + piece * 8) = (u32x4){zz, zz, zz, zz}; }
    }
}

__device__ __forceinline__ void norm_phase(const float* src_lat, const float* src_ctx, const float* nw, const float* mod_shift, const float* mod_scale, bf16_t* XN, int nrows) {
    const int tid = tidx(), lane = tid & 63, wave = tid >> 6;
    const int gw = bidx() * 8 + wave, NGW = gdim() * 8;
    f32x4 wv[4];
#pragma unroll
    for (int j = 0; j < 4; ++j) wv[j] = *(const f32x4*)(nw + 4 * lane + 256 * j);
    for (int r = gw; r < nrows; r += NGW) {
        const float* xr = r < MLAT ? src_lat + (size_t)r * DM : src_ctx + (size_t)(r - MLAT) * DM;
        const int set = r < SEQ ? 0 : (r < MLAT ? 1 : 2);
        f32x4 v[4]; float s = 0.f;
#pragma unroll
        for (int j = 0; j < 4; ++j) { v[j] = *(const f32x4*)(xr + 4 * lane + 256 * j); s += (v[j][0] * v[j][0] + v[j][1] * v[j][1]) + (v[j][2] * v[j][2] + v[j][3] * v[j][3]); }
        const float rstd = 1.0f / sqrtf(wave_sum(s) * (1.0f / DM) + NORM_EPS);
        bf16_t* orow = XN + (size_t)r * DM;
#pragma unroll
        for (int j = 0; j < 4; ++j) { const f32x4 sh = *(const f32x4*)(mod_shift + (size_t)set * 9 * DM + 4 * lane + 256 * j), sc = *(const f32x4*)(mod_scale + (size_t)set * 9 * DM + 4 * lane + 256 * j);
            const f32x4 y = v[j] * rstd * wv[j] * (sc + 1.0f) + sh;
            u32x2 w; w.x = pk2(y[0], y[1]); w.y = pk2(y[2], y[3]); *(u32x2*)(orow + 4 * lane + 256 * j) = w; }
    }
}
__device__ __forceinline__ void norm_rows(const float* src_lat, const float* src_ctx, const float* nw, const float* mod_shift, const float* mod_scale, bf16_t* XN, int r0, int nr) {
    const int tid = tidx(), lane = tid & 63, wave = tid >> 6;
    f32x4 wv[4];
#pragma unroll
    for (int j = 0; j < 4; ++j) wv[j] = *(const f32x4*)(nw + 4 * lane + 256 * j);
    for (int r = r0 + wave; r < r0 + nr; r += 8) {
        const float* xr = r < MLAT ? src_lat + (size_t)r * DM : src_ctx + (size_t)(r - MLAT) * DM;
        const int set = r < SEQ ? 0 : (r < MLAT ? 1 : 2);
        f32x4 v[4]; float s = 0.f;
#pragma unroll
        for (int j = 0; j < 4; ++j) { v[j] = *(const f32x4*)(xr + 4 * lane + 256 * j); s += (v[j][0] * v[j][0] + v[j][1] * v[j][1]) + (v[j][2] * v[j][2] + v[j][3] * v[j][3]); }
        const float rstd = 1.0f / sqrtf(wave_sum(s) * (1.0f / DM) + NORM_EPS);
        bf16_t* orow = XN + (size_t)r * DM;
#pragma unroll
        for (int j = 0; j < 4; ++j) { const f32x4 sh = *(const f32x4*)(mod_shift + (size_t)set * 9 * DM + 4 * lane + 256 * j), sc = *(const f32x4*)(mod_scale + (size_t)set * 9 * DM + 4 * lane + 256 * j);
            const f32x4 y = v[j] * rstd * wv[j] * (sc + 1.0f) + sh;
            u32x2 w; w.x = pk2(y[0], y[1]); w.y = pk2(y[2], y[3]); *(u32x2*)(orow + 4 * lane + 256 * j) = w; }
    }
}
__device__ __forceinline__ void final_norm_rows(float* out, const float* fw, int r0, int nr) {
    const int tid = tidx(), lane = tid & 63, wave = tid >> 6;
    f32x4 wv[4];
#pragma unroll
    for (int j = 0; j < 4; ++j) wv[j] = *(const f32x4*)(fw + 4 * lane + 256 * j);
    for (int r = r0 + wave; r < r0 + nr; r += 8) {
        float* xr = out + (size_t)r * DM;
        f32x4 v[4]; float s = 0.f;
#pragma unroll
        for (int j = 0; j < 4; ++j) { v[j] = *(const f32x4*)(xr + 4 * lane + 256 * j); s += (v[j][0] * v[j][0] + v[j][1] * v[j][1]) + (v[j][2] * v[j][2] + v[j][3] * v[j][3]); }
        const float rstd = 1.0f / sqrtf(wave_sum(s) * (1.0f / DM) + NORM_EPS);
#pragma unroll
        for (int j = 0; j < 4; ++j) *(f32x4*)(xr + 4 * lane + 256 * j) = v[j] * rstd * wv[j];
    }
}
__device__ __forceinline__ void final_norm_phase(float* out, const float* fw) {
    const int tid = tidx(), lane = tid & 63, wave = tid >> 6;
    const int gw = bidx() * 8 + wave, NGW = gdim() * 8;
    f32x4 wv[4];
#pragma unroll
    for (int j = 0; j < 4; ++j) wv[j] = *(const f32x4*)(fw + 4 * lane + 256 * j);
    for (int r = gw; r < MLAT; r += NGW) {
        float* xr = out + (size_t)r * DM;
        f32x4 v[4]; float s = 0.f;
#pragma unroll
        for (int j = 0; j < 4; ++j) { v[j] = *(const f32x4*)(xr + 4 * lane + 256 * j); s += (v[j][0] * v[j][0] + v[j][1] * v[j][1]) + (v[j][2] * v[j][2] + v[j][3] * v[j][3]); }
        const float rstd = 1.0f / sqrtf(wave_sum(s) * (1.0f / DM) + NORM_EPS);
#pragma unroll
        for (int j = 0; j < 4; ++j) *(f32x4*)(xr + 4 * lane + 256 * j) = v[j] * rstd * wv[j];
    }
}

__device__ __forceinline__ int chunk_row0(int b, int c) { return c < 64 ? b * SEQ + 128 * c : MLAT + b * CTXL + 128 * (c - 64); }

__device__ __forceinline__ void stage_rows_f32(const bf16_t* src, int ld, LAS float* dst, int tid) {
    const int j = tid >> 2, d0 = (tid & 3) * 16;
    const u32x4 a = *(const u32x4*)(src + (size_t)j * ld + d0), b = *(const u32x4*)(src + (size_t)j * ld + d0 + 8);
    LAS f32x4* o = (LAS f32x4*)(dst + j * 64 + d0);
    o[0] = (f32x4){bf_lo(a.x), bf_hi(a.x), bf_lo(a.y), bf_hi(a.y)}; o[1] = (f32x4){bf_lo(a.z), bf_hi(a.z), bf_lo(a.w), bf_hi(a.w)};
    o[2] = (f32x4){bf_lo(b.x), bf_hi(b.x), bf_lo(b.y), bf_hi(b.y)}; o[3] = (f32x4){bf_lo(b.z), bf_hi(b.z), bf_lo(b.w), bf_hi(b.w)};
}
__device__ __forceinline__ void stage_cols_f32(const bf16_t* src, LAS float* dst, int tid) {
    const int d = tid >> 3, j0 = (tid & 7) * 16;
    const u32x4 a = *(const u32x4*)(src + (size_t)d * MTOT + j0), b = *(const u32x4*)(src + (size_t)d * MTOT + j0 + 8);
    LAS float* o = dst + j0 * 64 + d;
    o[0 * 64] = bf_lo(a.x); o[1 * 64] = bf_hi(a.x); o[2 * 64] = bf_lo(a.y); o[3 * 64] = bf_hi(a.y); o[4 * 64] = bf_lo(a.z); o[5 * 64] = bf_hi(a.z); o[6 * 64] = bf_lo(a.w); o[7 * 64] = bf_hi(a.w);
    o[8 * 64] = bf_lo(b.x); o[9 * 64] = bf_hi(b.x); o[10 * 64] = bf_lo(b.y); o[11 * 64] = bf_hi(b.y); o[12 * 64] = bf_lo(b.z); o[13 * 64] = bf_hi(b.z); o[14 * 64] = bf_lo(b.w); o[15 * 64] = bf_hi(b.w);
}

__device__ __forceinline__ void attn_unit(const bf16_t* PN, const bf16_t* VT, bf16_t* YC, const float* sink, LAS unsigned char* lds, int b, int kvh, int qt, bool isctx) {
    const int tid = tidx(), i = tid & 127, g = tid >> 7, head = kvh * 4 + g;
    LAS float* Ks = (LAS float*)lds; LAS float* Vs = (LAS float*)(lds + 32768);
    const int row0 = isctx ? MLAT + b * CTXL + 128 * qt : b * SEQ + 128 * qt;
    float q[64], o[64];
    { const bf16_t* qp = PN + (size_t)(row0 + i) * PN_LD + 768 + head * 64;
#pragma unroll
      for (int c8 = 0; c8 < 8; ++c8) { const u32x4 a = *(const u32x4*)(qp + 8 * c8);
          q[8 * c8] = bf_lo(a.x); q[8 * c8 + 1] = bf_hi(a.x); q[8 * c8 + 2] = bf_lo(a.y); q[8 * c8 + 3] = bf_hi(a.y); q[8 * c8 + 4] = bf_lo(a.z); q[8 * c8 + 5] = bf_hi(a.z); q[8 * c8 + 6] = bf_lo(a.w); q[8 * c8 + 7] = bf_hi(a.w); } }
#pragma unroll
    for (int d = 0; d < 64; ++d) o[d] = 0.f;
    float mx = sink[head] * LOG2E, l = 1.0f;
    for (int ch = 0; ch < 5; ++ch) {
        int krow0;
        if (ch < 3) { if (isctx) continue; const int kb = qt - 1 + ch; if (kb < 0 || kb >= 64) continue; krow0 = b * SEQ + 128 * kb; }
        else krow0 = MLAT + b * CTXL + 128 * (ch - 3);
        __syncthreads();
        stage_rows_f32(PN + (size_t)krow0 * PN_LD + 1280 + kvh * 64, PN_LD, Ks, tid);
        stage_cols_f32(VT + (size_t)(256 + kvh * 64) * MTOT + krow0, Vs, tid);
        __syncthreads();
        for (int j = 0; j < 128; ++j) {
            const bool valid = (ch == 0) ? (j >= i) : ((ch == 2) ? (j <= i) : true);
            if (valid) {
                const LAS f32x4* kr = (const LAS f32x4*)(Ks + j * 64);
                float s0 = 0.f, s1 = 0.f;
#pragma unroll
                for (int d4 = 0; d4 < 16; ++d4) { const f32x4 kv = kr[d4]; s0 += q[4 * d4] * kv[0] + q[4 * d4 + 2] * kv[2]; s1 += q[4 * d4 + 1] * kv[1] + q[4 * d4 + 3] * kv[3]; if ((d4 & 3) == 3) asm volatile("" ::: "memory"); }
                const float s = s0 + s1;
                if (s > mx) { const float a = fexp2(mx - s); l *= a;
#pragma unroll
                    for (int d = 0; d < 64; ++d) o[d] *= a;
                    mx = s; }
                const float p = fexp2(s - mx); l += p;
                const LAS f32x4* vr = (const LAS f32x4*)(Vs + j * 64);
#pragma unroll
                for (int d4 = 0; d4 < 16; ++d4) { const f32x4 vv = vr[d4]; o[4 * d4] += p * vv[0]; o[4 * d4 + 1] += p * vv[1]; o[4 * d4 + 2] += p * vv[2]; o[4 * d4 + 3] += p * vv[3]; if ((d4 & 3) == 3) asm volatile("" ::: "memory"); }
            }
        }
    }
    const float inv = 1.0f / l;
    bf16_t* op = YC + (size_t)(row0 + i) * DM + 512 + head * 64;
#pragma unroll
    for (int c8 = 0; c8 < 8; ++c8) { u32x4 w; w.x = pk2(o[8 * c8] * inv, o[8 * c8 + 1] * inv); w.y = pk2(o[8 * c8 + 2] * inv, o[8 * c8 + 3] * inv); w.z = pk2(o[8 * c8 + 4] * inv, o[8 * c8 + 5] * inv); w.w = pk2(o[8 * c8 + 6] * inv, o[8 * c8 + 7] * inv);
        *(u32x4*)(op + 8 * c8) = w; }
    __syncthreads();
}

__device__ __forceinline__ void ret_kv_unit(const bf16_t* PN, const bf16_t* VT, float* KV, const float* decay  , LAS unsigned char* lds, int b, int h, int c) {
    const int tid = tidx();
    LAS float* Ks = (LAS float*)lds; LAS float* Vs = (LAS float*)(lds + 32768); LAS f32x2* wt = (LAS f32x2*)(lds + 65536);
    const int row0 = chunk_row0(b, c);
    __syncthreads();
    stage_rows_f32(PN + (size_t)row0 * PN_LD + 256 + h * 64, PN_LD, Ks, tid);
    stage_cols_f32(VT + (size_t)(h * 64) * MTOT + row0, Vs, tid);
    if (tid < 128) { const float lg0 = decay[h], lg1 = decay[4 + h]; wt[tid] = (f32x2){fexp2(lg0 * (float)(127 - tid)), fexp2(lg1 * (float)tid)}; }
    __syncthreads();
    const int a = tid & 63, b0 = (tid >> 6) * 8;
    float acc0[8], acc1[8];
#pragma unroll
    for (int e = 0; e < 8; ++e) { acc0[e] = 0.f; acc1[e] = 0.f; }
#pragma unroll 4
    for (int p = 0; p < 128; ++p) {
        const float k = Ks[p * 64 + a]; const f32x2 w = wt[p]; const float k0 = k * w.x, k1 = k * w.y;
        const f32x4 va = *(const LAS f32x4*)(Vs + p * 64 + b0), vb = *(const LAS f32x4*)(Vs + p * 64 + b0 + 4);
        acc0[0] += k0 * va[0]; acc0[1] += k0 * va[1]; acc0[2] += k0 * va[2]; acc0[3] += k0 * va[3]; acc0[4] += k0 * vb[0]; acc0[5] += k0 * vb[1]; acc0[6] += k0 * vb[2]; acc0[7] += k0 * vb[3];
        acc1[0] += k1 * va[0]; acc1[1] += k1 * va[1]; acc1[2] += k1 * va[2]; acc1[3] += k1 * va[3]; acc1[4] += k1 * vb[0]; acc1[5] += k1 * vb[1]; acc1[6] += k1 * vb[2]; acc1[7] += k1 * vb[3];
    }
    float* o0 = KV + ((size_t)((0 * 2 + b) * 4 + h) * NCHUNK + c) * 4096 + a;
    float* o1 = KV + ((size_t)((1 * 2 + b) * 4 + h) * NCHUNK + c) * 4096 + a;
#pragma unroll
    for (int e = 0; e < 8; ++e) { o0[(b0 + e) * 64] = acc0[e]; o1[(b0 + e) * 64] = acc1[e]; }
}

__device__ __forceinline__ void ret_scan_unit(float* KV, const float* decay, int unit) {
    const int e = unit * 512 + tidx(), seq = e >> 12, idx = e & 4095, dir = seq >> 3, h = seq & 3;
    const float Gd = fexp2(decay[dir * 4 + h] * 128.0f);
    float* base = KV + (size_t)seq * NCHUNK * 4096 + idx;
    float v[NCHUNK];
#pragma unroll
    for (int st = 0; st < NCHUNK; ++st) { const int c = (dir == 0) ? (st < 2 ? 64 + st : st - 2) : 65 - st; v[st] = base[(size_t)c * 4096]; }
    float S = 0.f;
#pragma unroll
    for (int st = 0; st < NCHUNK; ++st) { const float kv = v[st]; v[st] = S; S = S * Gd + kv; }
#pragma unroll
    for (int st = 0; st < NCHUNK; ++st) { const int c = (dir == 0) ? (st < 2 ? 64 + st : st - 2) : 65 - st; base[(size_t)c * 4096] = v[st]; }
}

__device__ __forceinline__ void ret_out_unit(const bf16_t* PN, const bf16_t* VT, const float* KV, bf16_t* YC, const float* decay, const float* gnw  , LAS unsigned char* lds, int b, int h, int c) {
    const int tid = tidx(), p = tid & 127, dvq = tid >> 7;
    LAS float* Ks = (LAS float*)lds; LAS float* Vs = (LAS float*)(lds + 32768); LAS float* S0 = (LAS float*)(lds + 65536); LAS float* S1 = (LAS float*)(lds + 81920); LAS float* red = (LAS float*)(lds + 98304); LAS float* Qs = (LAS float*)(lds + 102400);
    const int row0 = chunk_row0(b, c);
    __syncthreads();
    stage_rows_f32(PN + (size_t)row0 * PN_LD + 256 + h * 64, PN_LD, Ks, tid);
    stage_cols_f32(VT + (size_t)(h * 64) * MTOT + row0, Vs, tid);
    { const float* s0 = KV + ((size_t)((0 * 2 + b) * 4 + h) * NCHUNK + c) * 4096 + tid * 8; const float* s1 = KV + ((size_t)((1 * 2 + b) * 4 + h) * NCHUNK + c) * 4096 + tid * 8;
      const f32x4 a0 = *(const f32x4*)s0, a1 = *(const f32x4*)(s0 + 4), b0 = *(const f32x4*)s1, b1 = *(const f32x4*)(s1 + 4);
      const int dv = tid >> 3, dk0 = (tid & 7) * 8;
#pragma unroll
      for (int e = 0; e < 4; ++e) { S0[(dk0 + e) * 64 + dv] = a0[e]; S0[(dk0 + 4 + e) * 64 + dv] = a1[e]; S1[(dk0 + e) * 64 + dv] = b0[e]; S1[(dk0 + 4 + e) * 64 + dv] = b1[e]; } }
    float q[64];
    { const bf16_t* qp = PN + (size_t)(row0 + p) * PN_LD + h * 64;
#pragma unroll
      for (int c8 = 0; c8 < 8; ++c8) { const u32x4 a = *(const u32x4*)(qp + 8 * c8);
          q[8 * c8] = bf_lo(a.x); q[8 * c8 + 1] = bf_hi(a.x); q[8 * c8 + 2] = bf_lo(a.y); q[8 * c8 + 3] = bf_hi(a.y); q[8 * c8 + 4] = bf_lo(a.z); q[8 * c8 + 5] = bf_hi(a.z); q[8 * c8 + 6] = bf_lo(a.w); q[8 * c8 + 7] = bf_hi(a.w); } }
    if (dvq == 0) {
#pragma unroll
        for (int d = 0; d < 64; ++d) Qs[p * 65 + d] = q[d]; }
    const float lg0 = decay[h], lg1 = decay[4 + h];
    __syncthreads();
    float out[16];
#pragma unroll
    for (int v = 0; v < 16; ++v) out[v] = 0.f;
    for (int pp = 0; pp < 128; ++pp) {
        const LAS f32x4* kr = (const LAS f32x4*)(Ks + pp * 64);
        float s0 = 0.f, s1 = 0.f;
#pragma unroll
        for (int d4 = 0; d4 < 16; ++d4) { const f32x4 kv = kr[d4]; s0 += q[4 * d4] * kv[0] + q[4 * d4 + 2] * kv[2]; s1 += q[4 * d4 + 1] * kv[1] + q[4 * d4 + 3] * kv[3]; if ((d4 & 3) == 3) asm volatile("" ::: "memory"); }
        const float df = (float)(p - pp);
        const float dec = df > 0.f ? fexp2(lg0 * df) : (df < 0.f ? fexp2(-lg1 * df) : 2.0f);
        const float s = (s0 + s1) * dec;
        const LAS f32x4* vr = (const LAS f32x4*)(Vs + pp * 64 + dvq * 16);
#pragma unroll
        for (int v4 = 0; v4 < 4; ++v4) { const f32x4 vv = vr[v4]; out[4 * v4] += s * vv[0]; out[4 * v4 + 1] += s * vv[1]; out[4 * v4 + 2] += s * vv[2]; out[4 * v4 + 3] += s * vv[3]; }
    }
    {
        float x0[16], x1[16];
#pragma unroll
        for (int v = 0; v < 16; ++v) { x0[v] = 0.f; x1[v] = 0.f; }
#pragma unroll 2
        for (int dk = 0; dk < 64; ++dk) {
            const float t = Qs[p * 65 + dk];
            const LAS f32x4* r0 = (const LAS f32x4*)(S0 + dk * 64 + dvq * 16); const LAS f32x4* r1 = (const LAS f32x4*)(S1 + dk * 64 + dvq * 16);
#pragma unroll
            for (int v4 = 0; v4 < 4; ++v4) { const f32x4 a = r0[v4], bb = r1[v4];
                x0[4 * v4] += t * a[0]; x0[4 * v4 + 1] += t * a[1]; x0[4 * v4 + 2] += t * a[2]; x0[4 * v4 + 3] += t * a[3];
                x1[4 * v4] += t * bb[0]; x1[4 * v4 + 1] += t * bb[1]; x1[4 * v4 + 2] += t * bb[2]; x1[4 * v4 + 3] += t * bb[3]; }
        }
        const float f0 = fexp2(lg0 * (float)(p + 1)), f1 = fexp2(lg1 * (float)(128 - p));
#pragma unroll
        for (int v = 0; v < 16; ++v) out[v] += x0[v] * f0 + x1[v] * f1;
    }
    float s = 0.f;
#pragma unroll
    for (int v = 0; v < 16; ++v) s += out[v];
    red[dvq * 128 + p] = s;
    __syncthreads();
    const float mu = (red[p] + red[128 + p] + red[256 + p] + red[384 + p]) * (1.0f / 64.0f);
    float qv = 0.f;
#pragma unroll
    for (int v = 0; v < 16; ++v) { const float d = out[v] - mu; qv += d * d; }
    red[512 + dvq * 128 + p] = qv;
    __syncthreads();
    const float var = (red[512 + p] + red[640 + p] + red[768 + p] + red[896 + p]) * (1.0f / 64.0f);
    const float rstd = 1.0f / sqrtf(var + NORM_EPS);
    const bf16_t* gp = PN + (size_t)(row0 + p) * PN_LD + 512 + h * 64 + dvq * 16;
    const u32x4 ga = *(const u32x4*)gp, gb = *(const u32x4*)(gp + 8);
    float gt[16] = {bf_lo(ga.x), bf_hi(ga.x), bf_lo(ga.y), bf_hi(ga.y), bf_lo(ga.z), bf_hi(ga.z), bf_lo(ga.w), bf_hi(ga.w), bf_lo(gb.x), bf_hi(gb.x), bf_lo(gb.y), bf_hi(gb.y), bf_lo(gb.z), bf_hi(gb.z), bf_lo(gb.w), bf_hi(gb.w)};
    float y[16];
#pragma unroll
    for (int v = 0; v < 16; ++v) y[v] = silu_f(gt[v]) * ((out[v] - mu) * rstd * gnw[h * 64 + dvq * 16 + v]);
    bf16_t* op = YC + (size_t)(row0 + p) * DM + 256 + h * 64 + dvq * 16;
    u32x4 w0, w1;
    w0.x = pk2(y[0], y[1]); w0.y = pk2(y[2], y[3]); w0.z = pk2(y[4], y[5]); w0.w = pk2(y[6], y[7]);
    w1.x = pk2(y[8], y[9]); w1.y = pk2(y[10], y[11]); w1.z = pk2(y[12], y[13]); w1.w = pk2(y[14], y[15]);
    *(u32x4*)op = w0; *(u32x4*)(op + 8) = w1;
}

__device__ __forceinline__ f32x2 cmul(f32x2 a, f32x2 w) { return (f32x2){a.x * w.x - a.y * w.y, a.x * w.y + a.y * w.x}; }
__device__ __forceinline__ void fft_unit(const float* GT, bf16_t* YC, LAS unsigned char* lds, int b, int g, int m, bool isctx, int pflags = 0) {
    const int tid = tidx();
    const int logL = isctx ? 8 : 13, Lf = 1 << logL, tok0 = isctx ? MLAT + b * CTXL : b * SEQ;
    LAS f32x2* X = (LAS f32x2*)lds; const LAS f32x2* tw = (const LAS f32x2*)(lds + 73728);
    const float* gr = GT + (size_t)(g * 128 + m) * MTOT + tok0; const float* gi = (m == 0) ? gr + (size_t)32 * MTOT : gr + (size_t)64 * MTOT;
    __syncthreads();
    for (int i = tid; i < Lf; i += 512) X[i] = (f32x2){gr[i], gi[i]};
    __syncthreads();
    int s = 0;
    for (; s + 1 < logL; s += 2) {
        const int qb = logL - 2 - s, quarter = 1 << qb;
        const LAS f32x2* tw1 = tw + (8192 - (8192 >> (s + 13 - logL)));
        const LAS f32x2* tw2 = tw + (8192 - (8192 >> (s + 14 - logL)));
        for (int t = tid; t < (Lf >> 2); t += 512) {
            const int j = t & (quarter - 1), i0 = ((t >> qb) << (qb + 2)) + j;
            const f32x2 a = X[i0], bq = X[i0 + quarter], c = X[i0 + 2 * quarter], d = X[i0 + 3 * quarter];
            const f32x2 w1 = tw1[j], w2 = tw2[j];
            const f32x2 t0 = {a.x + c.x, a.y + c.y}, t1 = {a.x - c.x, a.y - c.y}, t2 = {bq.x + d.x, bq.y + d.y};
            const f32x2 t3 = {bq.y - d.y, d.x - bq.x};
            const f32x2 w3 = cmul(w1, w2);
            X[i0] = (f32x2){t0.x + t2.x, t0.y + t2.y};
            X[i0 + quarter] = cmul((f32x2){t0.x - t2.x, t0.y - t2.y}, w2);
            X[i0 + 2 * quarter] = cmul((f32x2){t1.x + t3.x, t1.y + t3.y}, w1);
            X[i0 + 3 * quarter] = cmul((f32x2){t1.x - t3.x, t1.y - t3.y}, w3);
        }
        __syncthreads();
    }
    if (s < logL) {
        for (int t = tid; t < (Lf >> 1); t += 512) { const f32x2 a = X[2 * t], bb = X[2 * t + 1]; X[2 * t] = (f32x2){a.x + bb.x, a.y + bb.y}; X[2 * t + 1] = (f32x2){a.x - bb.x, a.y - bb.y}; }
        __syncthreads();
    }
    const float scale = 1.0f / sqrtf((float)Lf * 64.0f);
    if (pflags & 2) return;
    unsigned* yo = (unsigned*)(YC + (size_t)tok0 * DM + g * 64 + 2 * m);
    const int sh = 32 - logL;
    if (m != 0) {
        for (int k = tid; k < Lf; k += 512) { const int i1 = (int)(__brev((unsigned)k) >> sh), i2 = (int)(__brev((unsigned)((Lf - k) & (Lf - 1))) >> sh);
            yo[(size_t)k * (DM / 2)] = pk2(X[i1].x * scale, X[i2].x * scale); }
    } else {
        const float hs = 0.5f * scale;
        for (int k = tid; k < Lf; k += 512) { const int i1 = (int)(__brev((unsigned)k) >> sh), i2 = (int)(__brev((unsigned)((Lf - k) & (Lf - 1))) >> sh);
            const f32x2 z = X[i1], zp = X[i2]; yo[(size_t)k * (DM / 2)] = pk2((z.x + zp.x) * hs, (z.y + zp.y) * hs); }
    }
}

typedef short bf16x8 __attribute__((ext_vector_type(8)));
typedef float f32x16 __attribute__((ext_vector_type(16)));
typedef __bf16 bf16x2_t __attribute__((ext_vector_type(2)));
#define MFMA32(a, b, c) __builtin_amdgcn_mfma_f32_32x32x16_bf16((a), (b), (c), 0, 0, 0)
__device__ __forceinline__ unsigned cvtpk(float lo, float hi) { f32x2 v = {lo, hi}; bf16x2_t b = __builtin_convertvector(v, bf16x2_t); return __builtin_bit_cast(unsigned, b); }
template <int S> __device__ __forceinline__ bf16x8 pack8(const f32x16& x) {
    u32x4 p; p.x = cvtpk(x[8 * S], x[8 * S + 1]); p.y = cvtpk(x[8 * S + 2], x[8 * S + 3]); p.z = cvtpk(x[8 * S + 4], x[8 * S + 5]); p.w = cvtpk(x[8 * S + 6], x[8 * S + 7]);
    return __builtin_bit_cast(bf16x8, p);
}
__device__ __forceinline__ f32x16 zero16() { f32x16 z; float zz = 0.f; asm volatile("" : "+v"(zz));
#pragma unroll
    for (int i = 0; i < 16; ++i) z[i] = zz;
    return z; }
__device__ __forceinline__ void ldg_rows(const bf16_t* src, int ld, int tid, u32x4& a, u32x4& b) { const bf16_t* p = src + (size_t)(tid >> 2) * ld + (tid & 3) * 16; a = *(const u32x4*)p; b = *(const u32x4*)(p + 8); }
__device__ __forceinline__ void sts_rows(LAS unsigned char* dst, int tid, const u32x4& a, const u32x4& b) { LAS u32x4* o = (LAS u32x4*)(dst + (tid >> 2) * 144 + (tid & 3) * 32); o[0] = a; o[1] = b; }
__device__ __forceinline__ void ldg_cols(const bf16_t* src, int tid, u32x4& a, u32x4& b) { const bf16_t* p = src + (size_t)(tid >> 3) * MTOT + (tid & 7) * 16; a = *(const u32x4*)p; b = *(const u32x4*)(p + 8); }
__device__ __forceinline__ void sts_cols(LAS unsigned char* dst, int tid, const u32x4& a, const u32x4& b) { LAS u32x2* o = (LAS u32x2*)(dst + (tid >> 3) * 264 + (tid & 7) * 32);
    o[0] = (u32x2){a.x, a.y}; o[1] = (u32x2){a.z, a.w}; o[2] = (u32x2){b.x, b.y}; o[3] = (u32x2){b.z, b.w}; }
__device__ __forceinline__ bf16x8 vt_frag(const LAS unsigned char* Vt, int frow, int k0, int hi) {
    const LAS unsigned char* vp = Vt + frow * 264 + (k0 + 4 * hi) * 2; const u32x2 lo = *(const LAS u32x2*)vp, hh = *(const LAS u32x2*)(vp + 16);
    return __builtin_bit_cast(bf16x8, (u32x4){lo.x, lo.y, hh.x, hh.y});
}

__device__ __forceinline__ void attn_unit_mfma(const bf16_t* PN, const bf16_t* VT, bf16_t* YC, const float* sink, LAS unsigned char* lds, int b, int kvh, int qt, bool isctx) {
    const int tid = tidx(), lane = tid & 63, wid = __builtin_amdgcn_readfirstlane(tid >> 6), q32 = lane & 31, hi = lane >> 5;
    const int g = wid >> 1, qh = wid & 1, head = kvh * 4 + g;
    const int row0 = isctx ? MLAT + b * CTXL + 128 * qt : b * SEQ + 128 * qt;
    LAS unsigned char* Ks = lds; LAS unsigned char* Vt = lds + 18432;
    LAS unsigned char* Qf = lds + 36864 + wid * 8192 + lane * 16;
    __syncthreads();
#pragma unroll
    for (int qs = 0; qs < 2; ++qs)
#pragma unroll
        for (int ks = 0; ks < 4; ++ks) *(LAS bf16x8*)(Qf + (qs * 4 + ks) * 1024) = *(const bf16x8*)(PN + (size_t)(row0 + 64 * qh + 32 * qs + q32) * PN_LD + 768 + head * 64 + 16 * ks + 8 * hi);
    f32x16 o[2][2];
#pragma unroll
    for (int qs = 0; qs < 2; ++qs) { o[qs][0] = zero16(); o[qs][1] = zero16(); }
    const float sk = sink[head] * LOG2E;
    float mx[2] = {sk, sk}; float l[2] = {hi ? 0.f : 1.f, hi ? 0.f : 1.f};
    unsigned mask = isctx ? 0x18u : (0x1Au | (qt > 0 ? 1u : 0u) | (qt < 63 ? 4u : 0u));
    int ch = __builtin_ctz(mask);
    u32x4 ka, kb, va, vb;
    { const int krow0 = ch < 3 ? b * SEQ + 128 * (qt - 1 + ch) : MLAT + b * CTXL + 128 * (ch - 3);
      ldg_rows(PN + (size_t)krow0 * PN_LD + 1280 + kvh * 64, PN_LD, tid, ka, kb); ldg_cols(VT + (size_t)(256 + kvh * 64) * MTOT + krow0, tid, va, vb); }
    for (;;) {
        __syncthreads();
        sts_rows(Ks, tid, ka, kb); sts_cols(Vt, tid, va, vb);
        __syncthreads();
        mask &= mask - 1u;
        const int cur = ch;
        if (mask) { ch = __builtin_ctz(mask); const int krow0 = ch < 3 ? b * SEQ + 128 * (qt - 1 + ch) : MLAT + b * CTXL + 128 * (ch - 3);
            const int t2 = tidx();
            ldg_rows(PN + (size_t)krow0 * PN_LD + 1280 + kvh * 64, PN_LD, t2, ka, kb); ldg_cols(VT + (size_t)(256 + kvh * 64) * MTOT + krow0, t2, va, vb); }
        const float sgnbig = (cur == 0) ? 1e30f : -1e30f;
#pragma unroll
        for (int kt = 0; kt < 4; ++kt) {
            asm volatile("" ::: "memory");
            f32x16 s[2]; s[0] = zero16(); s[1] = zero16();
#pragma unroll
            for (int ks = 0; ks < 4; ++ks) { const bf16x8 a = *(const LAS bf16x8*)(Ks + (kt * 32 + q32) * 144 + ks * 32 + hi * 16);
                s[0] = MFMA32(a, *(const LAS bf16x8*)(Qf + (0 * 4 + ks) * 1024), s[0]); s[1] = MFMA32(a, *(const LAS bf16x8*)(Qf + (1 * 4 + ks) * 1024), s[1]); }
            bf16x8 pk[2][2];
#pragma unroll
            for (int qs = 0; qs < 2; ++qs) {
                if (cur == 0 || cur == 2) {
                    float thr = (float)(64 * qh + 32 * qs + q32 - 4 * hi); asm volatile("" : "+v"(thr));
#pragma unroll
                    for (int r = 0; r < 16; ++r) { const float jc = (float)(kt * 32 + (r & 3) + 8 * (r >> 2)); s[qs][r] += fminf(0.f, (jc - thr) * sgnbig); } }
                float mloc = fmaxf(fmaxf(s[qs][0], s[qs][1]), fmaxf(s[qs][2], s[qs][3]));
#pragma unroll
                for (int r = 4; r < 16; r += 4) mloc = fmaxf(mloc, fmaxf(fmaxf(s[qs][r], s[qs][r + 1]), fmaxf(s[qs][r + 2], s[qs][r + 3])));
                mloc = fmaxf(mloc, __shfl_xor(mloc, 32));
                const float mnew = fmaxf(mx[qs], mloc), alpha = fexp2(mx[qs] - mnew); mx[qs] = mnew;
                float ls = 0.f;
#pragma unroll
                for (int r = 0; r < 16; ++r) { const float p = fexp2(s[qs][r] - mnew); s[qs][r] = p; ls += p; }
                l[qs] = l[qs] * alpha + ls;
                if (__builtin_amdgcn_ballot_w64(alpha != 1.0f)) { o[qs][0] = o[qs][0] * alpha; o[qs][1] = o[qs][1] * alpha; }
                pk[qs][0] = pack8<0>(s[qs]); pk[qs][1] = pack8<1>(s[qs]);
            }
#pragma unroll
            for (int dt = 0; dt < 2; ++dt) {
                const bf16x8 va = vt_frag(Vt, dt * 32 + q32, kt * 32, hi), vb = vt_frag(Vt, dt * 32 + q32, kt * 32 + 16, hi);
                o[0][dt] = MFMA32(va, pk[0][0], o[0][dt]); o[1][dt] = MFMA32(va, pk[1][0], o[1][dt]);
                o[0][dt] = MFMA32(vb, pk[0][1], o[0][dt]); o[1][dt] = MFMA32(vb, pk[1][1], o[1][dt]); }
        }
        if (!mask) break;
    }
    const int t3 = tidx(), q32b = t3 & 31, hib = (t3 >> 5) & 1;
#pragma unroll
    for (int qs = 0; qs < 2; ++qs) {
        const float lt = l[qs] + __shfl_xor(l[qs], 32), inv = 1.0f / lt;
        bf16_t* op = YC + (size_t)(row0 + 64 * qh + 32 * qs + q32b) * DM + 512 + head * 64;
#pragma unroll
        for (int dt = 0; dt < 2; ++dt)
#pragma unroll
            for (int rg = 0; rg < 4; ++rg) { u32x2 w; w.x = cvtpk(o[qs][dt][4 * rg] * inv, o[qs][dt][4 * rg + 1] * inv); w.y = cvtpk(o[qs][dt][4 * rg + 2] * inv, o[qs][dt][4 * rg + 3] * inv);
                *(u32x2*)(op + dt * 32 + 8 * rg + 4 * hib) = w; }
    }
}

__device__ __forceinline__ void ret_out_unit_mfma(const bf16_t* PN, const bf16_t* VT, const float* KV, bf16_t* YC, const float* decay, const float* gnw, LAS unsigned char* lds, int b, int h, int c) {
    const int tid = tidx(), lane = tid & 63, wid = __builtin_amdgcn_readfirstlane(tid >> 6), q32 = lane & 31, hi = lane >> 5;
    const int pt = wid >> 1, dt = wid & 1;
    LAS unsigned char* Ks = lds; LAS unsigned char* Vt = lds + 18432; LAS unsigned char* S0t = lds + 35328; LAS unsigned char* S1t = lds + 44544; LAS float* Out = (LAS float*)(lds + 53760);
    const int row0 = chunk_row0(b, c);
    __syncthreads();
    { u32x4 ka, kb, va, vb; ldg_rows(PN + (size_t)row0 * PN_LD + 256 + h * 64, PN_LD, tid, ka, kb); ldg_cols(VT + (size_t)(h * 64) * MTOT + row0, tid, va, vb);
      const float* s0 = KV + ((size_t)((0 * 2 + b) * 4 + h) * NCHUNK + c) * 4096 + tid * 8; const float* s1 = KV + ((size_t)((1 * 2 + b) * 4 + h) * NCHUNK + c) * 4096 + tid * 8;
      const f32x4 a0 = *(const f32x4*)s0, a1 = *(const f32x4*)(s0 + 4), b0 = *(const f32x4*)s1, b1 = *(const f32x4*)(s1 + 4);
      sts_rows(Ks, tid, ka, kb); sts_cols(Vt, tid, va, vb);
      const int dv = tid >> 3, dk0 = (tid & 7) * 8;
      *(LAS u32x4*)(S0t + dv * 144 + dk0 * 2) = (u32x4){cvtpk(a0[0], a0[1]), cvtpk(a0[2], a0[3]), cvtpk(a1[0], a1[1]), cvtpk(a1[2], a1[3])};
      *(LAS u32x4*)(S1t + dv * 144 + dk0 * 2) = (u32x4){cvtpk(b0[0], b0[1]), cvtpk(b0[2], b0[3]), cvtpk(b1[0], b1[1]), cvtpk(b1[2], b1[3])}; }
    bf16x8 qf[4];
#pragma unroll
    for (int ks = 0; ks < 4; ++ks) qf[ks] = *(const bf16x8*)(PN + (size_t)(row0 + 32 * pt + q32) * PN_LD + h * 64 + 16 * ks + 8 * hi);
    const float lg0 = decay[h], lg1 = decay[4 + h];
    __syncthreads();
    const int p = 32 * pt + q32;
    f32x16 o = zero16();
#pragma unroll
    for (int kt = 0; kt < 4; ++kt) {
        f32x16 s = zero16();
#pragma unroll
        for (int ks = 0; ks < 4; ++ks) { const bf16x8 a = *(const LAS bf16x8*)(Ks + (kt * 32 + q32) * 144 + ks * 32 + hi * 16); s = MFMA32(a, qf[ks], s); }
#pragma unroll
        for (int r = 0; r < 16; ++r) { const int pp = kt * 32 + (r & 3) + 8 * (r >> 2) + 4 * hi; const float df = (float)(p - pp);
            const float ex = fexp2((df > 0.f ? lg0 : -lg1) * df); const float dec = (df == 0.f) ? 2.0f : ex; s[r] *= dec; }
        o = MFMA32(vt_frag(Vt, dt * 32 + q32, kt * 32, hi), pack8<0>(s), o);
        o = MFMA32(vt_frag(Vt, dt * 32 + q32, kt * 32 + 16, hi), pack8<1>(s), o);
    }
    {   f32x16 x0 = zero16(), x1 = zero16();
#pragma unroll
        for (int ks = 0; ks < 4; ++ks) { const bf16x8 a0 = *(const LAS bf16x8*)(S0t + (dt * 32 + q32) * 144 + ks * 32 + hi * 16), a1 = *(const LAS bf16x8*)(S1t + (dt * 32 + q32) * 144 + ks * 32 + hi * 16);
            x0 = MFMA32(a0, qf[ks], x0); x1 = MFMA32(a1, qf[ks], x1); }
        const float f0 = fexp2(lg0 * (float)(p + 1)), f1 = fexp2(lg1 * (float)(128 - p));
        o = o + x0 * f0 + x1 * f1; }
#pragma unroll
    for (int rg = 0; rg < 4; ++rg) *(LAS f32x4*)(Out + p * 68 + dt * 32 + 8 * rg + 4 * hi) = (f32x4){o[4 * rg], o[4 * rg + 1], o[4 * rg + 2], o[4 * rg + 3]};
    __syncthreads();
    const int p2 = tid >> 2, dvq = tid & 3;
    float out[16];
#pragma unroll
    for (int v4 = 0; v4 < 4; ++v4) { const f32x4 t = *(const LAS f32x4*)(Out + p2 * 68 + dvq * 16 + 4 * v4); out[4 * v4] = t[0]; out[4 * v4 + 1] = t[1]; out[4 * v4 + 2] = t[2]; out[4 * v4 + 3] = t[3]; }
    float sm = 0.f;
#pragma unroll
    for (int v = 0; v < 16; ++v) sm += out[v];
    sm += __shfl_xor(sm, 1); sm += __shfl_xor(sm, 2);
    const float mu = sm * (1.0f / 64.0f);
    float qv = 0.f;
#pragma unroll
    for (int v = 0; v < 16; ++v) { const float d = out[v] - mu; qv += d * d; }
    qv += __shfl_xor(qv, 1); qv += __shfl_xor(qv, 2);
    const float rstd = 1.0f / sqrtf(qv * (1.0f / 64.0f) + NORM_EPS);
    const bf16_t* gp = PN + (size_t)(row0 + p2) * PN_LD + 512 + h * 64 + dvq * 16;
    const u32x4 ga = *(const u32x4*)gp, gb = *(const u32x4*)(gp + 8);
    const float gt[16] = {bf_lo(ga.x), bf_hi(ga.x), bf_lo(ga.y), bf_hi(ga.y), bf_lo(ga.z), bf_hi(ga.z), bf_lo(ga.w), bf_hi(ga.w), bf_lo(gb.x), bf_hi(gb.x), bf_lo(gb.y), bf_hi(gb.y), bf_lo(gb.z), bf_hi(gb.z), bf_lo(gb.w), bf_hi(gb.w)};
    float y[16];
#pragma unroll
    for (int v = 0; v < 16; ++v) y[v] = silu_f(gt[v]) * ((out[v] - mu) * rstd * gnw[h * 64 + dvq * 16 + v]);
    bf16_t* op = YC + (size_t)(row0 + p2) * DM + 256 + h * 64 + dvq * 16;
    u32x4 w0, w1;
    w0.x = cvtpk(y[0], y[1]); w0.y = cvtpk(y[2], y[3]); w0.z = cvtpk(y[4], y[5]); w0.w = cvtpk(y[6], y[7]);
    w1.x = cvtpk(y[8], y[9]); w1.y = cvtpk(y[10], y[11]); w1.z = cvtpk(y[12], y[13]); w1.w = cvtpk(y[14], y[15]);
    *(u32x4*)op = w0; *(u32x4*)(op + 8) = w1;
}

__device__ __forceinline__ void ret_kv_unit_mfma(const bf16_t* PN, const bf16_t* VT, float* KV, const float* decay, LAS unsigned char* lds, int b, int h, int c) {
    const int tid = tidx(), lane = tid & 63, wid = __builtin_amdgcn_readfirstlane(tid >> 6), q32 = lane & 31, hi = lane >> 5;
    const int dir = wid >> 2, dt = (wid >> 1) & 1, nt = wid & 1;
    LAS unsigned char* Ks = lds; LAS unsigned char* Vt = lds + 18432; LAS f32x2* wt = (LAS f32x2*)(lds + 35328);
    const int row0 = chunk_row0(b, c);
    __syncthreads();
    { u32x4 ka, kb, va, vb; ldg_rows(PN + (size_t)row0 * PN_LD + 256 + h * 64, PN_LD, tid, ka, kb); ldg_cols(VT + (size_t)(h * 64) * MTOT + row0, tid, va, vb);
      sts_rows(Ks, tid, ka, kb); sts_cols(Vt, tid, va, vb);
      if (tid < 128) wt[tid] = (f32x2){fexp2(decay[h] * (float)(127 - tid)), fexp2(decay[4 + h] * (float)tid)}; }
    __syncthreads();
    f32x16 acc = zero16();
#pragma unroll
    for (int ks = 0; ks < 8; ++ks) {
        const LAS unsigned char* vp = Vt + (32 * dt + q32) * 264 + (16 * ks + 8 * hi) * 2;
        const u32x2 lo = *(const LAS u32x2*)vp, hh = *(const LAS u32x2*)(vp + 8);
        const bf16x8 a = __builtin_bit_cast(bf16x8, (u32x4){lo.x, lo.y, hh.x, hh.y});
        float kw[8];
#pragma unroll
        for (int e = 0; e < 8; ++e) { const int p = 16 * ks + 8 * hi + e; const unsigned kv = *(const LAS unsigned short*)(Ks + p * 144 + (32 * nt + q32) * 2);
            const f32x2 w = wt[p]; kw[e] = __builtin_bit_cast(float, kv << 16) * (dir ? w.y : w.x); }
        const bf16x8 bq = __builtin_bit_cast(bf16x8, (u32x4){cvtpk(kw[0], kw[1]), cvtpk(kw[2], kw[3]), cvtpk(kw[4], kw[5]), cvtpk(kw[6], kw[7])});
        acc = MFMA32(a, bq, acc);
    }
    float* o = KV + ((size_t)((dir * 2 + b) * 4 + h) * NCHUNK + c) * 4096 + 32 * nt + q32;
#pragma unroll
    for (int r = 0; r < 16; ++r) o[(32 * dt + (r & 3) + 8 * (r >> 2) + 4 * hi) * 64] = acc[r];
}

typedef __attribute__((address_space(4))) const Params* KParams;
__device__ __forceinline__ KParams kparams() { KParams p = (KParams)__builtin_amdgcn_kernarg_segment_ptr(); asm volatile("" : "+s"(p)); return p; }
struct UniEpi {
    static constexpr bool PERM = false, AFTER_DRAIN = false;
    int mode;
    int L;
    int midx;
    LAS unsigned char* xl;
    __device__ __forceinline__ void operator()(const f32x4 (&acc)[2][2][4][2], const Unit& u, int wr, int wc, int fr, int fq) const {
        KParams K = kparams(); unsigned char* ws = K->ws;
        if (mode == 3 || mode == 4) return;
        if (mode == 0) { EpiSwiglu E{(bf16_t*)(ws + OFF_ACT)}; E(acc, u, wr, wc, fr, fq); }
        else if (mode == 1) { const bool first = (midx & 256) != 0; const int mi = midx & 255; float* HC = (float*)(ws + OFF_HC);
            EpiResid E{first ? K->x : K->out, first ? K->ctx : HC, K->out, HC, (const float*)(ws + OFF_MOD) + (size_t)(L * 27 + mi) * DM, mi == 5 ? 1.0f : 0.5f}; E(acc, u, wr, wc, fr, fq); }
        else { EpiInProj E{(bf16_t*)(ws + OFF_PN), (float*)(ws + OFF_GT), (bf16_t*)(ws + OFF_VT), (const float*)(ws + OFF_ROPE), 66 + 10 * L, 72 + 10 * L}; E(acc, u, wr, wc, fr, fq); }
    }
    __device__ __forceinline__ void tail(f32x4 (&acc)[2][2][4][2], const Unit& u, int wr, int wc, int fr, int fq) const {
        if (mode != 4) return;
        KParams K = kparams(); unsigned char* ws = K->ws;
        { const bool first = (midx & 256) != 0; const int mi = midx & 255; float* HC = (float*)(ws + OFF_HC);
            const int kk = mi == 2 ? 0 : (mi == 5 ? 1 : 2), nL = (kk == 2 && L == 0) ? 1 : L, widx = (kk == 0) ? 1 : (kk == 1 ? 2 : 0), ni = (kk == 0) ? 3 : (kk == 1 ? 6 : 0);
            const float* modN = (const float*)(ws + OFF_MOD) + (size_t)nL * 27 * DM;
            epi_resid_norm(acc, u, wr, wc, fr, fq, first ? K->x : K->out, first ? K->ctx : HC, K->out, HC, (const float*)(ws + OFF_MOD) + (size_t)(L * 27 + mi) * DM, mi == 5 ? 1.0f : 0.5f,
                           K->norm_w + (size_t)(nL * 3 + widx) * DM, modN + (size_t)ni * DM, modN + (size_t)(ni + 1) * DM, (bf16_t*)(ws + OFF_R),
                           (float*)(ws + OFF_XBUF) + (size_t)(L * 3 + kk) * MTOT * 4, (unsigned*)(ws + OFF_BAR + 65536) + (size_t)((L * 3 + kk) * 66) * 64, xl, (L == 1 && kk == 2) ? K->final_norm_w : nullptr); }
    }
};
__device__ __forceinline__ void gate_signal(unsigned* cnt) {
    asm volatile("s_waitcnt vmcnt(0)" ::: "memory");
    __builtin_amdgcn_fence(__ATOMIC_RELEASE, "agent");
    asm volatile("s_waitcnt vmcnt(0)" ::: "memory");
    if ((tidx() & 63) == 0) __hip_atomic_fetch_add(cnt, 1u, __ATOMIC_RELAXED, __HIP_MEMORY_SCOPE_AGENT);
}
__device__ __forceinline__ void gate_wait(unsigned* cnt, unsigned need) {
    if (tidx() < 64) { unsigned sp = 0;
        while ((unsigned)__builtin_amdgcn_readfirstlane(__hip_atomic_load(cnt, __ATOMIC_RELAXED, __HIP_MEMORY_SCOPE_AGENT)) < need) { __builtin_amdgcn_s_sleep(2); if (++sp > (1u << 22)) break; }
        __builtin_amdgcn_fence(__ATOMIC_ACQUIRE, "agent"); asm volatile("s_waitcnt vmcnt(0)" ::: "memory"); }
    __syncthreads();
}
__device__ __forceinline__ void wg_signal(unsigned* cnt) {
    asm volatile("s_waitcnt vmcnt(0)" ::: "memory"); __syncthreads();
    if (tidx() == 0) { __builtin_amdgcn_fence(__ATOMIC_RELEASE, "agent"); asm volatile("s_waitcnt vmcnt(0)" ::: "memory"); __hip_atomic_fetch_add(cnt, 1u, __ATOMIC_RELAXED, __HIP_MEMORY_SCOPE_AGENT); }
}
constexpr int NDED = 8, NWORK = 256 - NDED;
struct UniSched {
    int mode; pg8::StaticOrder so; int L; unsigned* cnt;
    __device__ __forceinline__ bool next(int i, Unit& u) const {
        if (mode == 0) return so.next(i, u);
        if (mode == 1) { InSched is{so.G, so.c, 66 + 10 * L, 72 + 10 * L}; return is.next(i, u); }
        if (mode == 2) { if (so.c >= NWORK) return false; const int lin = i * NWORK + so.c;
            if (lin < 44) { u.pm = 64 + lin / 22; u.pn = lin % 22; return true; }
            if (lin - 44 >= 64 * 22) return false;
            pg8::StaticOrder t = so; t.G = 0; t.c = lin - 44; return t.next(0, u); }
        if (i > 0 || so.c < NWORK) return false;
        u.pm = 64 + ((so.c - NWORK) >> 2); u.pn = (so.c - NWORK) & 3; return true;
    }
    __device__ __forceinline__ void a_ready(const Unit&) const {}
    __device__ __forceinline__ void done(const Unit& u) const { if (mode == 2 && cnt != nullptr && u.pm >= 64) gate_signal(cnt); }
};


#ifdef ATT_VALU
#define ATTN_FN attn_unit
#else
#define ATTN_FN attn_unit_mfma
#endif
#ifdef KV_VALU
#define KV_FN ret_kv_unit
#else
#define KV_FN ret_kv_unit_mfma
#endif
#ifdef RO_VALU
#define RO_FN ret_out_unit
#else
#define RO_FN ret_out_unit_mfma
#endif

constexpr int LDS_ST_OFF = LDS_BYTES - 16;
__device__ __forceinline__ void grid_barrier(LAS unsigned char* lds) {
#ifdef USE_CG_SYNC
    cg::this_grid().sync();
#else
    XcdBarrier b; b.bar = (unsigned*)(kparams()->ws + OFF_BAR); b.x = xb_xcc_id(); b.st = (volatile LAS unsigned*)(lds + LDS_ST_OFF);
    xcd_barrier(b);
#endif
}
#ifndef FUSE_NORM
#define FUSE_NORM 1
#endif
#ifndef MERGE_MIX
#define MERGE_MIX 0
#endif
#ifndef FUSE2
#define FUSE2 1
#endif
#ifndef FUSE_FINAL
#define FUSE_FINAL 0
#endif
__global__ void __launch_bounds__(512) fwd_megakernel(Params Pin) {
    extern __shared__ __attribute__((aligned(16))) unsigned char lds_raw[];
    LAS unsigned char* lds = (LAS unsigned char*)lds_raw;
#ifndef USE_CG_SYNC
    if (tidx() < 4) ((LAS unsigned*)(lds + LDS_ST_OFF))[tidx()] = 0u;
    __syncthreads();
    (void)xcd_barrier_post((unsigned*)(kparams()->ws + OFF_BAR), (volatile LAS unsigned*)(lds + LDS_ST_OFF));
    if (kparams()->ws == nullptr) cg::this_grid().sync();
#endif
#ifdef PROBE_REP
#define NREP(t) ((((PROBE_REP) >> (t)) & 1) ? 2 : 1)
#define XSYNC() do { if (((PROBE_REP) >> 9) & 1) grid_barrier(lds); } while (0)
#else
#define NREP(t) 1
#define XSYNC() do {} while (0)
#endif
    for (int rep = 0; rep < NREP(0); ++rep) {
#ifndef NO_P0
        p0_prologue(*kparams(), lds);
#endif
    }
    grid_barrier(lds); XSYNC();
    for (int L = 0; L < 2; ++L)
    for (int r = 0; r < 12; ++r) {
        const int ptype = (r == 0 || r == 3 || r == 9) ? 1 : ((r == 1 || r == 10) ? 2 : ((r == 2 || r == 11) ? 3 : r));
        const int nrep = NREP(ptype);
      for (int rep = 0; rep < nrep; ++rep) {
        KParams K = kparams();
        unsigned char* ws = K->ws;
        const int G = gdim(), bx = bidx();
        {

            const float* modL = (const float*)(ws + OFF_MOD) + (size_t)L * 3 * 9 * DM;
            float* HC = (float*)(ws + OFF_HC);
            bf16_t* Rb = (bf16_t*)(ws + OFF_R);
            if ((r == 0 || r == 3 || r == 9) && !((FUSE_NORM || FUSE2) && G == 256 && !(L == 0 && r == 0))) {
                const bool first = (L == 0 && r == 0);
                const int widx = r == 0 ? 0 : (r == 3 ? 1 : 2), mi = r;
                const int nrows = (r == 9 && L == 1) ? MLAT : MTOT;
                norm_phase(first ? K->x : K->out, first ? K->ctx : HC, K->norm_w + (size_t)(L * 3 + widx) * DM, modL + (size_t)(mi == 9 ? 6 : mi) * DM, modL + (size_t)((mi == 9 ? 6 : mi) + 1) * DM, Rb, nrows);
            }
            int gk = 0;
            const bool split_ctx = (G == 256);
            if (r == 1 || r == 10) gk = 1; else if (r == 2 || r == 11) gk = 2; else if (r == 4) gk = 3; else if (r == 8) gk = 4;
            if (r >= 5 && r <= 7) {
                unsigned* ctl = (unsigned*)(ws + OFF_BAR) + 4096;

                const bf16_t* PN = (const bf16_t*)(ws + OFF_PN); const bf16_t* VT = (const bf16_t*)(ws + OFF_VT); bf16_t* YC = (bf16_t*)(ws + OFF_YCAT);
                float* KV = (float*)(ws + OFF_KV); const float* GT = (const float*)(ws + OFF_GT);
                const float* decay = (const float*)(ws + OFF_LG) + L * 8;
                if (MERGE_MIX && r == 5 && split_ctx) {
                    unsigned* kvc = ctl + (6 + L * 2) * 64; unsigned* scc = ctl + (7 + L * 2) * 64;
                    { const int tid = tidx(); const f32x2* twg = (const f32x2*)(ws + OFF_TW); LAS f32x2* tws = (LAS f32x2*)(lds + 73728); for (int i = tid; i < 8191; i += 512) tws[i] = twg[i]; }
                    for (int u = bx; u < 8 * NCHUNK; u += G) { const int c = u % NCHUNK, bh = u / NCHUNK;
                        KV_FN(PN, VT, KV, decay, lds, bh >> 2, bh & 3, c);
                        if (rep == 0) wg_signal(kvc); }
                    { const int bg = bx & 7, mm = bx >> 3;
                      fft_unit(GT, YC, lds, bg >> 2, bg & 3, mm, false, 0);
                      if (L == 0) fft_unit(GT, YC, lds, bg >> 2, bg & 3, mm, true, 0); }
                    ATTN_FN(PN, VT, YC, K->attn_sink + L * 8, lds, bx >> 7, (bx >> 6) & 1, bx & 63, false);
                    if (L == 0 && bx < 8) ATTN_FN(PN, VT, YC, K->attn_sink + L * 8, lds, bx >> 2, (bx >> 1) & 1, bx & 1, true);
                    if (rep == 0) {
                        gate_wait(kvc, 8 * NCHUNK);
                        if (bx < 128) { ret_scan_unit(KV, decay, bx); wg_signal(scc); }
                    }
                    gate_wait(scc, 128);
                    if (L == 0) {
                        unsigned* cnt = ctl + (L * 3 + 2) * 64;
                        if (bx < NWORK) {
                            for (int u = bx; u < 8 * NCHUNK; u += NWORK) {
                                const bool isc = u < 16; const int v = u - 16; const int bh = isc ? (u >> 1) : (v >> 6), c = isc ? 64 + (u & 1) : (v & 63);
                                RO_FN(PN, VT, KV, YC, decay, K->ret_gn_w + L * 256, lds, bh >> 2, bh & 3, c);
                                if (isc) gate_signal(cnt);
                            }
                        } else gk = 5;
                    } else {
                        for (int u = bx; u < 8 * 64; u += G) RO_FN(PN, VT, KV, YC, decay, K->ret_gn_w + L * 256, lds, (u >> 6) >> 2, (u >> 6) & 3, u & 63);
                    }
                } else if (MERGE_MIX && split_ctx) {
                } else if (r == 5) {
                    { const int tid = tidx(); const f32x2* twg = (const f32x2*)(ws + OFF_TW); LAS f32x2* tws = (LAS f32x2*)(lds + 73728); for (int i = tid; i < 8191; i += 512) tws[i] = twg[i]; }
                    for (int u = bx; u < 8 * NCHUNK; u += G) { const int c = u % NCHUNK, bh = u / NCHUNK;
#ifndef NO_KV
#ifdef PROBE_REP
                        if (rep > 0 && ((PROBE_REP) & 0x800)) continue;
#endif
                        KV_FN(PN, VT, KV, decay, lds, bh >> 2, bh & 3, c);
#endif
                    }
#ifndef NO_FFT
                    if (G == 256) {
#ifdef PROBE_REP
                      if (!(rep > 0 && ((PROBE_REP) & 0x400)))
#endif
                      {
                        const int bg = bx & 7, mm = bx >> 3;
#ifdef PROBE_REP
                        const int pf = rep > 0 ? (((PROBE_REP) >> 12) & 7) : 0;
#else
                        const int pf = 0;
#endif
                        fft_unit(GT, YC, lds, bg >> 2, bg & 3, mm, false, pf);
                        if (L == 0) fft_unit(GT, YC, lds, bg >> 2, bg & 3, mm, true, pf);
                      }
                    } else {
                        for (int u = bx; u < 256 * (L == 0 ? 2 : 1); u += G) { const int v = u & 255; fft_unit(GT, YC, lds, (v & 7) >> 2, v & 3, v >> 3, u >= 256, 0); }
                    }
#endif
                } else if (r == 6) {
                    const int n_sc = 128, n_al = 256, n_ac = (L == 0 && !split_ctx) ? 8 : 0;
                    for (int u = bx; u < n_sc + n_al + n_ac; u += G) {
                        if (u < n_sc) {
#ifndef NO_SCAN
                            if (rep == 0) ret_scan_unit(KV, decay, u);
#endif
                        } else {
                            const int v = u - n_sc; const bool isc = v >= n_al; const int w = v - n_al;
#ifndef NO_ATT
                            ATTN_FN(PN, VT, YC, K->attn_sink + L * 8, lds, isc ? (w >> 2) : (v >> 7), isc ? ((w >> 1) & 1) : ((v >> 6) & 1), isc ? (w & 1) : (v & 63), isc);
#endif
                        }
                    }
                } else {
                    if (L == 0 && split_ctx) {
                        unsigned* cnt = ctl + (L * 3 + 2) * 64;
                        if (bx < NWORK) {
                            for (int u = bx; u < 8 * NCHUNK; u += NWORK) {
                                const bool isc = u < 16; const int v = u - 16; const int bh = isc ? (u >> 1) : (v >> 6), c = isc ? 64 + (u & 1) : (v & 63);
#ifndef NO_RO
                                RO_FN(PN, VT, KV, YC, decay, K->ret_gn_w + L * 256, lds, bh >> 2, bh & 3, c);
                                if (isc) gate_signal(cnt);
#endif
                            }
                        } else {
                            const int w = bx - NWORK;
                            ATTN_FN(PN, VT, YC, K->attn_sink + L * 8, lds, w >> 2, (w >> 1) & 1, w & 1, true);
                            wg_signal(ctl + 12 * 64);
                            gate_wait(ctl + 12 * 64, (unsigned)NDED * (unsigned)(rep + 1));
                            gk = 5;
                        }
                    } else {
                        const int cpb = (L == 0) ? NCHUNK : 64, n_ro = 8 * cpb;
                        for (int u = bx; u < n_ro; u += G) { const int c = u % cpb, bh = u / cpb;
#ifndef NO_RO
                            RO_FN(PN, VT, KV, YC, decay, K->ret_gn_w + L * 256, lds, bh >> 2, bh & 3, c);
#endif
                        }
                    }
                }
            }
            if (gk != 0) {
                unsigned* ctl = (unsigned*)(ws + OFF_BAR) + 4096;
                const int j = (r == 10 || r == 11) ? 1 : 0; const bool with_ctx = !(L == 1 && j == 1);
                const int npass = (gk == 1 && with_ctx && split_ctx && rep == 0) ? 2 : 1;
                for (int pass = 0; pass < npass; ++pass) {
                    pg8::Gemm g; UniSched S; UniEpi E; unsigned* gate = nullptr; unsigned gate_need = 0;
                    E.mode = 0; E.L = L; E.midx = 0; S.mode = 0; S.L = L; S.cnt = nullptr;
                    int M = MTOT, N = DM; g.K = DM;
                    if (gk == 1 && pass == 0) {
                        N = 2 * DFF; g.A = Rb; g.Bt = (const bf16_t*)(ws + OFF_WFFIN + (size_t)(L * 2 + j) * SZ_WFFIN);
                        if (with_ctx && split_ctx) { M = MLAT; S.mode = 2; if (rep == 0) S.cnt = ctl + (L * 3 + j) * 64; } else M = with_ctx ? MTOT : MLAT;
                    } else if (gk == 2 || gk == 1) {
                        g.A = (const bf16_t*)(ws + OFF_ACT); g.Bt = (const bf16_t*)(ws + OFF_WFFOUT + (size_t)(L * 2 + j) * SZ_WFFOUT); g.K = DFF;
                        E.mode = 1; E.midx = (j == 0 ? 2 : 8) | ((L == 0 && j == 0) ? 256 : 0);
                        if (gk == 1) { S.mode = 3; gate = ctl + (L * 3 + j) * 64; gate_need = 44 * 8; } else M = (with_ctx && !split_ctx) ? MTOT : MLAT;
                    } else if (gk == 3) {
                        g.A = Rb; g.Bt = Rb; S.mode = 1; E.mode = 2;
                    } else {
                        g.A = (const bf16_t*)(ws + OFF_YCAT); g.Bt = (const bf16_t*)(ws + OFF_WO + (size_t)L * SZ_WO); E.mode = 1; E.midx = 5;
                        if (gk == 5) { S.mode = 3; gate = ctl + (L * 3 + 2) * 64; gate_need = 16 * 8; } else M = (L == 0 && !split_ctx) ? MTOT : MLAT;
                    }
                    E.xl = lds + 131072;
                    if (FUSE2 && split_ctx && E.mode == 1) E.mode = 4;
                    if (rep > 0 && (E.mode == 1 || E.mode == 4)) E.mode = 3;
                    g.M = M; g.N = N; S.so.init(M, N, G, bx);
                    if (gate != nullptr && bx >= NWORK) gate_wait(gate, gate_need);
#ifndef NO_GEMM
                    pg8::gemm_phase<UniEpi, UniSched, true, true>(lds, g, S, E);
#endif
                    if (FUSE_NORM && rep == 0 && (gk == 2 || gk == 4 || gk == 5 || (gk == 1 && pass == 1)) && gdim() == 256) {
                        const int jj = (r == 10 || r == 11) ? 1 : 0;
                        if (L == 1 && gk == 2 && jj == 1) { if (FUSE_FINAL) {
                            const int bx2 = bidx(); pg8::StaticOrder so2; so2.init(MLAT, DM, 256, bx2); Unit u0; so2.next(0, u0);
                            KParams K2 = kparams(); unsigned* pc = (unsigned*)(K2->ws + OFF_BAR + 65536) + (size_t)((L * 3 + 2) * 66 + u0.pm) * 64;
                            if (tidx() == 0) { __builtin_amdgcn_fence(__ATOMIC_RELEASE, "agent"); asm volatile("s_waitcnt vmcnt(0)" ::: "memory"); __hip_atomic_fetch_add(pc, 1u, __ATOMIC_RELAXED, __HIP_MEMORY_SCOPE_AGENT); }
                            gate_wait(pc, 4u);
                            final_norm_rows(K2->out, K2->final_norm_w, 256 * u0.pm + 64 * u0.pn, 64); }
                        } else {
                            const int bx2 = bidx(); int pm, pn;
                            if (gk == 2 || gk == 4) { pg8::StaticOrder so2; so2.init(MLAT, DM, 256, bx2); Unit u0; so2.next(0, u0); pm = u0.pm; pn = u0.pn; }
                            else { pm = bx2 >= NWORK ? 64 + ((bx2 - NWORK) >> 2) : -1; pn = (bx2 - NWORK) & 3; }
                            if (pm >= 0) {
                                KParams K2 = kparams(); unsigned char* ws2 = K2->ws;
                                const int kk = (gk == 4 || gk == 5) ? 1 : (jj == 0 ? 0 : 2);
                                unsigned* pc = (unsigned*)(ws2 + OFF_BAR + 65536) + (size_t)((L * 3 + kk) * 66 + pm) * 64;
                                if (tidx() == 0) { __builtin_amdgcn_fence(__ATOMIC_RELEASE, "agent"); asm volatile("s_waitcnt vmcnt(0)" ::: "memory"); __hip_atomic_fetch_add(pc, 1u, __ATOMIC_RELAXED, __HIP_MEMORY_SCOPE_AGENT); }
                                gate_wait(pc, 4u);
                                const int nL = (kk == 2) ? L + 1 : L, widx = (kk == 0) ? 1 : (kk == 1 ? 2 : 0), mi = (kk == 0) ? 3 : (kk == 1 ? 6 : 0);
                                const float* modN = (const float*)(ws2 + OFF_MOD) + (size_t)nL * 3 * 9 * DM;
                                norm_rows(K2->out, (const float*)(ws2 + OFF_HC), K2->norm_w + (size_t)(nL * 3 + widx) * DM, modN + (size_t)mi * DM, modN + (size_t)(mi + 1) * DM, (bf16_t*)(ws2 + OFF_R), 256 * pm + 64 * pn, 64);
                            }
                        }
                    }
                }
            }
        }
      }
        if ((FUSE_NORM || FUSE2) && gdim() == 256 && (r == 3 || r == 9 || (r == 0 && L == 1) || (MERGE_MIX && (r == 6 || r == 7)) || ((FUSE_FINAL || FUSE2) && r == 11 && L == 1))) continue;
        grid_barrier(lds); XSYNC();
    }
    if (!(((FUSE_NORM && FUSE_FINAL) || FUSE2) && gdim() == 256)) { KParams K = kparams(); final_norm_phase(K->out, K->final_norm_w); }
}

extern "C" void kernel_launch(void* const* d_in, const int* in_sizes, int n_in, void* d_out, int out_size, void* d_ws, size_t ws_size, hipStream_t stream) {
    static int grid_blocks = 0;
    if (grid_blocks == 0) {
        if (n_in != 15 || ws_size < WS_NEED) { fprintf(stderr, "kernel_launch: unexpected n_in %d or ws_size %zu (need %zu)\n", n_in, ws_size, (size_t)WS_NEED); grid_blocks = -1; return; }
        int dev = 0, cus = 0, per_cu = 0;
        (void)hipGetDevice(&dev);
        (void)hipDeviceGetAttribute(&cus, hipDeviceAttributeMultiprocessorCount, dev);
        (void)hipFuncSetAttribute((const void*)fwd_megakernel, hipFuncAttributeMaxDynamicSharedMemorySize, LDS_BYTES);
        (void)hipOccupancyMaxActiveBlocksPerMultiprocessor(&per_cu, (const void*)fwd_megakernel, 512, LDS_BYTES);
        if (per_cu < 1) fprintf(stderr, "kernel_launch: occupancy query says %d blocks/CU\n", per_cu);
        grid_blocks = cus;
        (void)hipGetLastError();
    }
    if (grid_blocks < 0) return;
    Params p{};
    p.x = (const float*)d_in[0]; p.c = (const float*)d_in[1]; p.ctx = (const float*)d_in[2]; p.c_ctx = (const float*)d_in[3]; p.norm_w = (const float*)d_in[4];
    p.w_ada = (const float*)d_in[5]; p.b_ada = (const float*)d_in[6]; p.ffn_w_in = (const float*)d_in[7]; p.ffn_w_out = (const float*)d_in[8]; p.w_in = (const float*)d_in[9];
    p.w_o = (const float*)d_in[10]; p.ret_decay = (const float*)d_in[11]; p.ret_gn_w = (const float*)d_in[12]; p.attn_sink = (const float*)d_in[13]; p.final_norm_w = (const float*)d_in[14];
    p.out = (float*)d_out; p.ws = (unsigned char*)d_ws;
#ifndef USE_CG_SYNC
    (void)hipMemsetAsync((char*)d_ws + OFF_BAR, 0, 262144, stream);
#endif
    void* args[] = {&p};
    hipError_t e = hipLaunchCooperativeKernel((const void*)fwd_megakernel, dim3(grid_blocks), dim3(512), args, LDS_BYTES, stream);
    if (e != hipSuccess) fprintf(stderr, "cooperative launch failed: %s (grid %d)\n", hipGetErrorString(e), grid_blocks);
}
```
